# Optimizing an MI355X kernel written in HIP

```python
import math
import jax, jax.numpy as jnp
from jax import lax
import numpy as np

D_MODEL = 2048
BATCH = 1
SEQ = 8192
DEPTH = 2
DEC_BATCH = 8
DEC_SEQ = 64
PAST_LEN = 2048

CHUNK = 64
H_MLSTM = 4
DH_MLSTM = 256
W_MLSTM = H_MLSTM * DH_MLSTM
H_ATT = 8
DH_ATT = 128
W_ATT = H_ATT * DH_ATT
W_MIX = W_MLSTM + W_ATT
BAND_CHUNKS = 8
BAND_PAST = BAND_CHUNKS * CHUNK
BAND_LEN = (BAND_CHUNKS + 1) * CHUNK
REL_CLIP = 256
N_REL = 2 * REL_CLIP + 1
N_MEM = 256
H_MEM = 4
DH_MEM = 128
W_MEM = H_MEM * DH_MEM
D_FF = 5632
CONV_W = 3
EPS = 1e-6
NEG = -1e30
F_BIAS_LO = 3.0
F_BIAS_HI = 6.0
IN_SIZES = (W_MLSTM, W_MLSTM, W_MLSTM, H_MLSTM, H_MLSTM, W_MLSTM, W_ATT, W_ATT, W_ATT)
N_IN = sum(IN_SIZES)

kernel_name = "hybrid_mlstm_chunkband_stream_step"


def rmsnorm(x, g):
    x32 = x.astype(jnp.float32)
    y = x32 * lax.rsqrt(jnp.mean(x32 * x32, axis=-1, keepdims=True) + EPS) * g.astype(jnp.float32)
    return y.astype(x.dtype)


def mix_projections(h, w_in, b_i, b_f):
    B, T = h.shape[:2]
    z = h @ w_in
    offs = [int(o) for o in np.cumsum(IN_SIZES)[:-1]]
    qm, km, vm, ig, fg, og, qa, ka, va = jnp.split(z, offs, axis=-1)
    f32 = jnp.float32
    qm = qm.reshape(B, T, H_MLSTM, DH_MLSTM).astype(f32)
    km = km.reshape(B, T, H_MLSTM, DH_MLSTM).astype(f32) * (DH_MLSTM ** -0.5)
    vm = vm.reshape(B, T, H_MLSTM, DH_MLSTM).astype(f32)
    ig = (ig + b_i).astype(f32)
    lf = jax.nn.log_sigmoid((fg + b_f).astype(f32))
    o = jax.nn.sigmoid(og)
    qa = qa.reshape(B, T, H_ATT, DH_ATT)
    ka = ka.reshape(B, T, H_ATT, DH_ATT)
    va = va.reshape(B, T, H_ATT, DH_ATT)
    return (qm, km, vm, ig, lf, o), (qa, ka, va)


def _to_chunks(a, L):
    B, T = a.shape[:2]
    a = a.reshape((B, T // L, L) + a.shape[2:])
    return a.transpose((1, 0, 3, 2) + tuple(range(4, a.ndim)))


def _mlstm_chunk(carry, xs):
    C, n, m = carry
    q, k, v, ig, lf = xs
    L = q.shape[2]
    b = jnp.cumsum(lf, axis=-1)
    causal = jnp.tril(jnp.ones((L, L), dtype=bool))
    Dm = jnp.where(causal, b[..., :, None] - b[..., None, :] + ig[..., None, :], NEG)
    inter = b + m[..., None]
    m_t = jnp.maximum(inter, jnp.max(Dm, axis=-1))
    w_inter = jnp.exp(inter - m_t)
    P = jnp.exp(Dm - m_t[..., None]) * jnp.einsum('bhtd,bhsd->bhts', q, k)
    num = w_inter[..., None] * jnp.einsum('bhvk,bhtk->bhtv', C, q) + jnp.einsum('bhts,bhsv->bhtv', P, v)
    den = w_inter * jnp.einsum('bhk,bhtk->bht', n, q) + jnp.sum(P, axis=-1)
    h = num / jnp.maximum(jnp.abs(den), jnp.exp(-m_t))[..., None]
    b_L = b[..., -1]
    g = b_L[..., None] - b + ig
    m_new = jnp.maximum(b_L + m, jnp.max(g, axis=-1))
    a_old = jnp.exp(b_L + m - m_new)
    a_s = jnp.exp(g - m_new[..., None])
    C_new = a_old[..., None, None] * C + jnp.einsum('bhs,bhsv,bhsk->bhvk', a_s, v, k)
    n_new = a_old[..., None] * n + jnp.einsum('bhs,bhsk->bhk', a_s, k)
    return (C_new, n_new, m_new), h


def mlstm_scan(q, k, v, ig, lf, C0, n0, m0, L):
    B, T = q.shape[:2]
    xs = (_to_chunks(q, L), _to_chunks(k, L), _to_chunks(v, L), _to_chunks(ig, L), _to_chunks(lf, L))
    (C, n, m), h = lax.scan(_mlstm_chunk, (C0, n0, m0), xs)
    h = h.transpose(1, 0, 3, 2, 4).reshape(B, T, H_MLSTM, DH_MLSTM)
    return (C, n, m), h


def mlstm_out(hm, o, g_head):
    B, T = hm.shape[:2]
    hn = hm * lax.rsqrt(jnp.mean(hm * hm, axis=-1, keepdims=True) + EPS) * g_head.astype(jnp.float32)
    return o * hn.reshape(B, T, W_MLSTM).astype(o.dtype)


def band_attention_prompt(q, k, v, rel_bias):
    B, T, H, d = q.shape
    nc = T // CHUNK
    qc = q.reshape(B, nc, CHUNK, H, d)

    def band(a):
        a = a.reshape(B, nc, CHUNK, H, d)
        a = jnp.pad(a, ((0, 0), (BAND_CHUNKS, 0), (0, 0), (0, 0), (0, 0)))
        return jnp.concatenate([a[:, w:w + nc] for w in range(BAND_CHUNKS + 1)], axis=2)

    kb, vb = band(k), band(v)
    key_pos = jnp.arange(nc)[:, None] * CHUNK - BAND_PAST + jnp.arange(BAND_LEN)[None, :]
    valid = key_pos >= 0
    rel = BAND_PAST + jnp.arange(CHUNK)[:, None] - jnp.arange(BAND_LEN)[None, :]
    bias = rel_bias[:, jnp.clip(rel, -REL_CLIP, REL_CLIP) + REL_CLIP].astype(jnp.float32)
    s = jnp.einsum('bcqhd,bckhd->bchqk', qc, kb).astype(jnp.float32) * (d ** -0.5) + bias[None, None]
    s = jnp.where(valid[None, :, None, None, :], s, NEG)
    p = jax.nn.softmax(s, axis=-1).astype(v.dtype)
    o = jnp.einsum('bchqk,bckhd->bcqhd', p, vb)
    return o.reshape(B, T, H * d)


def band_attention_sample(q, k_new, v_new, k_cache, v_cache, rel_bias):
    B, S, H, d = q.shape
    Lc = k_cache.shape[1]
    kk = jnp.concatenate([k_cache.astype(k_new.dtype), k_new], axis=1)
    vv = jnp.concatenate([v_cache.astype(v_new.dtype), v_new], axis=1)
    rel = Lc + jnp.arange(S)[:, None] - jnp.arange(Lc + S)[None, :]
    bias = rel_bias[:, jnp.clip(rel, -REL_CLIP, REL_CLIP) + REL_CLIP].astype(jnp.float32)
    s = jnp.einsum('bqhd,bkhd->bhqk', q, kk).astype(jnp.float32) * (d ** -0.5) + bias[None]
    p = jax.nn.softmax(s, axis=-1).astype(vv.dtype)
    o = jnp.einsum('bhqk,bkhd->bqhd', p, vv)
    return o.reshape(B, S, H * d)


def mem_kv(mem, g, w_ckv):
    B, M = mem.shape[:2]
    z = rmsnorm(mem, g) @ w_ckv
    k, v = jnp.split(z, 2, axis=-1)
    return k.reshape(B, M, H_MEM, DH_MEM), v.reshape(B, M, H_MEM, DH_MEM)


def cross_attn(h, mk, mv, w_cq, w_co):
    B, T = h.shape[:2]
    q = (h @ w_cq).reshape(B, T, H_MEM, DH_MEM)
    s = jnp.einsum('bthd,bmhd->bhtm', q, mk.astype(q.dtype)).astype(jnp.float32) * (DH_MEM ** -0.5)
    p = jax.nn.softmax(s, axis=-1).astype(q.dtype)
    o = jnp.einsum('bhtm,bmhd->bthd', p, mv.astype(q.dtype)).reshape(B, T, W_MEM)
    return o @ w_co


def conv_ffn(h, conv_state, w_up, conv_w, conv_b, w_down):
    T = h.shape[1]
    u = h @ w_up
    ext = jnp.concatenate([conv_state.astype(u.dtype), u], axis=1)
    c = conv_b + sum(conv_w[j] * ext[:, j:j + T] for j in range(CONV_W))
    a, b = jnp.split(c, 2, axis=-1)
    y = (jax.nn.silu(a) * b) @ w_down
    return y, ext[:, -(CONV_W - 1):]


def setup_inputs(seed: int = 0) -> dict:
    key = jax.random.key(seed)
    ks = iter(jax.random.split(key, 40))
    f32 = jnp.float32

    def nrm(shape, scale=1.0):
        return jax.random.normal(next(ks), shape, f32) * scale

    def gain(shape):
        return 1.0 + nrm(shape, 0.01)

    att_rows = min(BAND_PAST, PAST_LEN)
    b_f = jnp.linspace(F_BIAS_LO, F_BIAS_HI, H_MLSTM, dtype=f32)[None, :] + nrm((DEPTH, H_MLSTM), 0.1)
    return {
        "x_prompt": nrm((BATCH, SEQ, D_MODEL)),
        "x_sample": nrm((DEC_BATCH, DEC_SEQ, D_MODEL)),
        "mem_prompt": nrm((BATCH, N_MEM, D_MODEL)),
        "cache_att_k": nrm((DEPTH, DEC_BATCH, att_rows, H_ATT, DH_ATT)),
        "cache_att_v": nrm((DEPTH, DEC_BATCH, att_rows, H_ATT, DH_ATT)),
        "cache_mem_k": nrm((DEPTH, DEC_BATCH, N_MEM, H_MEM, DH_MEM)),
        "cache_mem_v": nrm((DEPTH, DEC_BATCH, N_MEM, H_MEM, DH_MEM)),
        "state_mlstm_C": nrm((DEPTH, DEC_BATCH, H_MLSTM, DH_MLSTM, DH_MLSTM), 0.3),
        "state_mlstm_n": nrm((DEPTH, DEC_BATCH, H_MLSTM, DH_MLSTM), 0.3),
        "state_mlstm_m": nrm((DEPTH, DEC_BATCH, H_MLSTM), 0.5),
        "state_ffn_conv": nrm((DEPTH, DEC_BATCH, CONV_W - 1, 2 * D_FF)),
        "norm_mix_g": gain((DEPTH, D_MODEL)),
        "w_in": nrm((DEPTH, D_MODEL, N_IN), D_MODEL ** -0.5),
        "b_igate": nrm((DEPTH, H_MLSTM), 0.1),
        "b_fgate": b_f,
        "mlstm_head_g": gain((DEPTH, H_MLSTM, DH_MLSTM)),
        "rel_bias": nrm((DEPTH, H_ATT, N_REL), 0.1),
        "w_out": nrm((DEPTH, W_MIX, D_MODEL), W_MIX ** -0.5),
        "norm_cross_g": gain((DEPTH, D_MODEL)),
        "norm_mem_g": gain((DEPTH, D_MODEL)),
        "w_cq": nrm((DEPTH, D_MODEL, W_MEM), D_MODEL ** -0.5),
        "w_ckv": nrm((DEPTH, D_MODEL, 2 * W_MEM), D_MODEL ** -0.5),
        "w_co": nrm((DEPTH, W_MEM, D_MODEL), W_MEM ** -0.5),
        "norm_ffn_g": gain((DEPTH, D_MODEL)),
        "w_up": nrm((DEPTH, D_MODEL, 2 * D_FF), D_MODEL ** -0.5),
        "conv_w": nrm((DEPTH, CONV_W, 2 * D_FF), CONV_W ** -0.5),
        "conv_b": nrm((DEPTH, 2 * D_FF), 0.01),
        "w_down": nrm((DEPTH, D_FF, D_MODEL), D_FF ** -0.5),
        "norm_final_g": gain((D_MODEL,)),
    }


def reference(x_prompt, x_sample, mem_prompt, cache_att_k, cache_att_v, cache_mem_k, cache_mem_v,
              state_mlstm_C, state_mlstm_n, state_mlstm_m, state_ffn_conv,
              norm_mix_g, w_in, b_igate, b_fgate, mlstm_head_g, rel_bias, w_out,
              norm_cross_g, norm_mem_g, w_cq, w_ckv, w_co,
              norm_ffn_g, w_up, conv_w, conv_b, w_down, norm_final_g):
    f32 = jnp.float32
    xp, xs = x_prompt, x_sample
    Bp, T = xp.shape[:2]
    keep = min(BAND_PAST, T)
    pC, pn, pm, pk, pv, pmk, pmv, pconv = [], [], [], [], [], [], [], []
    sC, sn, sm, sk, sv, sconv = [], [], [], [], [], []
    for l in range(DEPTH):
        h = rmsnorm(xp, norm_mix_g[l])
        (qm, km, vm, ig, lf, o), (qa, ka, va) = mix_projections(h, w_in[l], b_igate[l], b_fgate[l])
        C0 = jnp.zeros((Bp, H_MLSTM, DH_MLSTM, DH_MLSTM), f32)
        n0 = jnp.zeros((Bp, H_MLSTM, DH_MLSTM), f32)
        m0 = jnp.zeros((Bp, H_MLSTM), f32)
        (C, n, m), hm = mlstm_scan(qm, km, vm, ig, lf, C0, n0, m0, CHUNK)
        ya = band_attention_prompt(qa, ka, va, rel_bias[l])
        xp = xp + jnp.concatenate([mlstm_out(hm, o, mlstm_head_g[l]), ya], axis=-1) @ w_out[l]
        mk, mv = mem_kv(mem_prompt, norm_mem_g[l], w_ckv[l])
        xp = xp + cross_attn(rmsnorm(xp, norm_cross_g[l]), mk, mv, w_cq[l], w_co[l])
        zc = jnp.zeros((Bp, CONV_W - 1, 2 * D_FF), xp.dtype)
        y, cst = conv_ffn(rmsnorm(xp, norm_ffn_g[l]), zc, w_up[l], conv_w[l], conv_b[l], w_down[l])
        xp = xp + y
        pC.append(C); pn.append(n); pm.append(m)
        pk.append(ka[:, T - keep:]); pv.append(va[:, T - keep:])
        pmk.append(mk); pmv.append(mv); pconv.append(cst)

        h = rmsnorm(xs, norm_mix_g[l])
        (qm, km, vm, ig, lf, o), (qa, ka, va) = mix_projections(h, w_in[l], b_igate[l], b_fgate[l])
        (C, n, m), hm = mlstm_scan(qm, km, vm, ig, lf, state_mlstm_C[l].astype(f32),
                                   state_mlstm_n[l].astype(f32), state_mlstm_m[l].astype(f32), xs.shape[1])
        ya = band_attention_sample(qa, ka, va, cache_att_k[l], cache_att_v[l], rel_bias[l])
        xs = xs + jnp.concatenate([mlstm_out(hm, o, mlstm_head_g[l]), ya], axis=-1) @ w_out[l]
        xs = xs + cross_attn(rmsnorm(xs, norm_cross_g[l]), cache_mem_k[l], cache_mem_v[l], w_cq[l], w_co[l])
        y, cst = conv_ffn(rmsnorm(xs, norm_ffn_g[l]), state_ffn_conv[l], w_up[l], conv_w[l], conv_b[l], w_down[l])
        xs = xs + y
        sC.append(C); sn.append(n); sm.append(m)
        sk.append(ka); sv.append(va); sconv.append(cst)

    y_prompt = rmsnorm(xp, norm_final_g)
    y_sample = rmsnorm(xs, norm_final_g)
    p_mlstm_C = jnp.stack(pC); p_mlstm_n = jnp.stack(pn); p_mlstm_m = jnp.stack(pm)
    p_att_k = jnp.stack(pk); p_att_v = jnp.stack(pv)
    p_mem_k = jnp.stack(pmk); p_mem_v = jnp.stack(pmv)
    p_ffn_conv = jnp.stack(pconv)
    s_mlstm_C = jnp.stack(sC); s_mlstm_n = jnp.stack(sn); s_mlstm_m = jnp.stack(sm)
    s_att_k = jnp.stack(sk); s_att_v = jnp.stack(sv)
    s_ffn_conv = jnp.stack(sconv)
    return (y_prompt, y_sample, p_mlstm_C, p_mlstm_n, p_mlstm_m, p_att_k, p_att_v, p_mem_k, p_mem_v,
            p_ffn_conv, s_mlstm_C, s_mlstm_n, s_mlstm_m, s_att_k, s_att_v, s_ffn_conv)
```

```cpp
#include <hip/hip_runtime.h>
#include <hip/hip_cooperative_groups.h>
#include <cstdio>
namespace cg = cooperative_groups;

namespace pg8 {
#define PG8_LAS __attribute__((address_space(3)))
typedef unsigned short bf16_t;
typedef short bf16x8 __attribute__((ext_vector_type(8)));
typedef float f32x4 __attribute__((ext_vector_type(4)));
typedef unsigned u32x4 __attribute__((ext_vector_type(4)));
constexpr int BM = 256, BK = 64, HALF = 128, HTB = HALF * BK * 2  , STAGE_BYTES = 8 * HTB, NXCD = 8, WGM = 8;

__host__ __device__ __forceinline__ int lds_byte(int r, int c) { const int st = (r >> 4) * 2 + (c >> 5), rr = r & 15, cc = c & 31, ob = rr * 64 + cc * 2; return st * 1024 + (ob ^ (((ob >> 9) & 1) << 5)); }
__host__ __device__ __forceinline__ void stage_rc(int b, int& R, int& C) { const int st = b / 1024, sb = b % 1024, swz = sb ^ (((sb >> 9) & 1) << 5); R = (st >> 1) * 16 + swz / 64; C = (st & 1) * 32 + (swz % 64) / 2; }
__host__ __device__ __forceinline__ int perm32(int rho) { const int n = rho >> 4, i = rho & 15; return 8 * (i >> 2) + 4 * n + (i & 3); }

struct Unit { int pm, pn; };
struct Gemm { const bf16_t* A; const bf16_t* Bt; int M, N, K; };

struct StaticOrder {
    int nM, nN, nwg, G, c;
    __host__ __device__ void init(int M, int N, int G_, int c_) { nM = M / BM; nN = N / BM; nwg = nM * nN; G = G_; c = c_; }
    __host__ __device__ bool next(int i, Unit& u) const {
        const long L = (long)i * G + c; if (L >= nwg) return false;
        int wgid = (int)L; { const int q = nwg / NXCD, r = nwg % NXCD, xcd = wgid % NXCD, off = wgid / NXCD; wgid = (xcd < r ? xcd * (q + 1) : r * (q + 1) + (xcd - r) * q) + off; }
        const int nig = WGM * nN, gid = wgid / nig, fm = gid * WGM, gsz = (nM - fm) < WGM ? (nM - fm) : WGM;
        u.pm = fm + ((wgid % nig) % gsz); u.pn = (wgid % nig) / gsz; return true;
    }
    __device__ __forceinline__ void a_ready(const Unit&) const {}
    __device__ __forceinline__ void done(const Unit&) const {}
};
typedef __bf16 bf16v2_t __attribute__((ext_vector_type(2)));
__device__ __forceinline__ unsigned cvt_pk_bf16(float lo, float hi) { bf16v2_t v; v[0] = (__bf16)lo; v[1] = (__bf16)hi; return __builtin_bit_cast(unsigned, v); }
template <class Epi, class Sched, bool STAMP = false>
__device__ __forceinline__ void gemm_phase(PG8_LAS unsigned char* lds, const Gemm g, const Sched& S, const Epi& E, unsigned long long* stamps) {
    int tid_ = threadIdx.x; asm volatile("" : "+v"(tid_)); const int tid = tid_, wid = __builtin_amdgcn_readfirstlane(tid >> 6), lane = tid & 63, wr = wid >> 2, wc = wid & 3, fr = lane & 15, fq = lane >> 4;
    const int K = g.K, nt = K / BK;
    int ts_lo = 0, ts_hi = 0, nts = 0; const unsigned long long rt_entry = STAMP ? (unsigned long long)wall_clock64() : 0ull;
#define PG8_STAMP() do { if (STAMP && wid == 0 && nts < 64) { const unsigned long long _c = (unsigned long long)clock64(); \
        ts_lo = (lane == nts) ? (int)(unsigned)_c : ts_lo; ts_hi = (lane == nts) ? (int)(unsigned)(_c >> 32) : ts_hi; ++nts; } } while (0)
    PG8_STAMP();
    unsigned voffA[2], voffB[2];
#pragma unroll
    for (int i = 0; i < 2; ++i) { int R, C; stage_rc(tid * 16 + i * 8192, R, C); const int Rb = Epi::PERM ? ((R & ~31) + perm32(R & 31)) : R;
        voffA[i] = (unsigned)(R * K + C) * 2u; voffB[i] = (unsigned)(Rb * K + C) * 2u; }
    const size_t kstep = (size_t)(BK * 2);
    const size_t hstep = (size_t)HALF * K * 2;
    const size_t tstep = 2 * hstep;
    const unsigned ldsw = (unsigned)wid * 1024u;
    const int aoff = lds_byte(wr * 64 + fr, fq * 8), boff = lds_byte(wc * 32 + fr, fq * 8);
#define PG8_SA(b, h) (((b) * 2 + (h)) * HTB)
#define PG8_SB(b, h) ((4 + (b) * 2 + (h)) * HTB)
#define PG8_STAGE(bufoff, gbase, voff) do { _Pragma("unroll") for (int _i = 0; _i < 2; ++_i) \
        __builtin_amdgcn_global_load_lds((const unsigned*)((const char*)(gbase) + (voff)[_i]), (PG8_LAS unsigned*)(lds + (bufoff) + ldsw + _i * 8192), 16, 0, 0); } while (0)
#define PG8_LDA(dst, b, h) do { _Pragma("unroll") for (int m = 0; m < 4; ++m) _Pragma("unroll") for (int k = 0; k < 2; ++k) dst[m][k] = *(const PG8_LAS bf16x8*)(lds + PG8_SA(b, h) + aoff + m * 2048 + k * 1024); } while (0)
#define PG8_LDB(dst, b, h) do { _Pragma("unroll") for (int n = 0; n < 2; ++n) _Pragma("unroll") for (int k = 0; k < 2; ++k) dst[n][k] = *(const PG8_LAS bf16x8*)(lds + PG8_SB(b, h) + boff + n * 2048 + k * 1024); } while (0)
#define PG8_MMA(ai, bj, At, Bt) do { __builtin_amdgcn_s_setprio(1); _Pragma("unroll") for (int m = 0; m < 4; ++m) _Pragma("unroll") for (int n = 0; n < 2; ++n) _Pragma("unroll") for (int k = 0; k < 2; ++k) \
        acc[ai][bj][m][n] = __builtin_amdgcn_mfma_f32_16x16x32_bf16(Bt[n][k], At[m][k], acc[ai][bj][m][n], 0, 0, 0); __builtin_amdgcn_s_setprio(0); } while (0)
#define PG8_WAIT_V(n) asm volatile("s_waitcnt vmcnt(" #n ")" ::: "memory")
#define PG8_WAIT_L(n) asm volatile("s_waitcnt lgkmcnt(" #n ")" ::: "memory")
#define PG8_BAR __builtin_amdgcn_s_barrier()
#define PG8_SCHED __builtin_amdgcn_sched_barrier(0)
    Unit cur, nxt; int ui = 0;
    if (!S.next(0, cur)) return;
    f32x4 acc[2][2][4][2];
#pragma unroll
    for (int a = 0; a < 2; ++a)
#pragma unroll
        for (int b = 0; b < 2; ++b)
#pragma unroll
            for (int m = 0; m < 4; ++m)
#pragma unroll
                for (int n = 0; n < 2; ++n) acc[a][b][m][n] = (f32x4){0.f, 0.f, 0.f, 0.f};
    bf16x8 At[4][2], B0[2][2], B1[2][2];
    const char* cA = (const char*)g.A + (size_t)cur.pm * tstep; const char* cB = (const char*)g.Bt + (size_t)cur.pn * tstep;
    S.a_ready(cur);
    PG8_STAGE(PG8_SB(0, 0), cB, voffB); PG8_STAGE(PG8_SA(0, 0), cA, voffA); PG8_STAGE(PG8_SB(0, 1), cB + hstep, voffB); PG8_STAGE(PG8_SA(0, 1), cA + hstep, voffA);
    if (wr == 1) PG8_BAR;
    PG8_WAIT_V(4); PG8_BAR;
    PG8_STAGE(PG8_SB(1, 0), cB + kstep, voffB); PG8_STAGE(PG8_SA(1, 0), cA + kstep, voffA); PG8_STAGE(PG8_SB(1, 1), cB + hstep + kstep, voffB);
    PG8_WAIT_V(6); PG8_BAR;
    PG8_STAMP();
    for (;;) {
        const bool has_next = S.next(ui + 1, nxt);
        const char* nA = has_next ? (const char*)g.A + (size_t)nxt.pm * tstep : cA; const char* nB = has_next ? (const char*)g.Bt + (size_t)nxt.pn * tstep : cB;
        for (int t = 0; t < nt; t += 2) {
            const bool last = (t == nt - 2);
            const char* a1 = cA + (size_t)(t + 1) * kstep;
            const char* a2 = last ? nA : cA + (size_t)(t + 2) * kstep; const char* b2 = last ? nB : cB + (size_t)(t + 2) * kstep;
            const char* a3 = a2 + kstep; const char* b3 = b2 + kstep;
            if (last && has_next) S.a_ready(nxt);
            PG8_LDB(B0, 0, 0); PG8_SCHED; PG8_LDA(At, 0, 0); PG8_STAGE(PG8_SA(1, 1), a1 + hstep, voffA);
            PG8_WAIT_L(8); PG8_BAR; PG8_WAIT_L(0); PG8_MMA(0, 0, At, B0); PG8_BAR; PG8_SCHED;
            PG8_LDB(B1, 0, 1); PG8_STAGE(PG8_SB(0, 0), b2, voffB);
            PG8_BAR; PG8_WAIT_L(0); PG8_MMA(0, 1, At, B1); PG8_BAR;
            PG8_LDA(At, 0, 1); PG8_STAGE(PG8_SA(0, 0), a2, voffA);
            PG8_BAR; PG8_WAIT_L(0); PG8_MMA(1, 0, At, B0); PG8_BAR; PG8_SCHED;
            PG8_STAGE(PG8_SB(0, 1), b2 + hstep, voffB);
            PG8_WAIT_V(6); PG8_BAR; PG8_MMA(1, 1, At, B1); PG8_BAR;
            PG8_LDB(B0, 1, 0); PG8_SCHED; PG8_LDA(At, 1, 0); PG8_STAGE(PG8_SA(0, 1), a2 + hstep, voffA);
            PG8_WAIT_L(8); PG8_BAR; PG8_WAIT_L(0); PG8_MMA(0, 0, At, B0); PG8_BAR; PG8_SCHED;
            PG8_LDB(B1, 1, 1); PG8_STAGE(PG8_SB(1, 0), b3, voffB);
            PG8_BAR; PG8_WAIT_L(0); PG8_MMA(0, 1, At, B1); PG8_BAR;
            PG8_LDA(At, 1, 1); PG8_STAGE(PG8_SA(1, 0), a3, voffA);
            PG8_BAR; PG8_WAIT_L(0); PG8_MMA(1, 0, At, B0); PG8_BAR; PG8_SCHED;
            PG8_STAGE(PG8_SB(1, 1), b3 + hstep, voffB);
            PG8_WAIT_V(6); PG8_BAR; PG8_MMA(1, 1, At, B1); PG8_BAR;
        }
        PG8_STAMP();
        if constexpr (!Epi::AFTER_DRAIN) { E(acc, cur, wr, wc, fr, fq); S.done(cur); }
        PG8_STAMP();
        if (!has_next) break;
#pragma unroll
        for (int a = 0; a < 2; ++a)
#pragma unroll
            for (int b = 0; b < 2; ++b)
#pragma unroll
                for (int m = 0; m < 4; ++m)
#pragma unroll
                    for (int n = 0; n < 2; ++n) acc[a][b][m][n] = (f32x4){0.f, 0.f, 0.f, 0.f};
        cur = nxt; cA = nA; cB = nB; ++ui;
    }
    PG8_WAIT_V(0);
    if (wr == 0) PG8_BAR;
    PG8_BAR;
    if constexpr (Epi::AFTER_DRAIN) { E.fused(acc, cur, wr, wc, fr, fq, lds, wid, lane); S.done(cur); }
    PG8_STAMP();
    if (STAMP && wid == 0) { stamps[lane] = lane < nts ? (((unsigned long long)(unsigned)ts_hi << 32) | (unsigned)ts_lo) : 0ull;
        if (lane == 62) stamps[62] = rt_entry; if (lane == 63) stamps[63] = (unsigned long long)wall_clock64(); }
#undef PG8_STAMP
#undef PG8_SA
#undef PG8_SB
#undef PG8_STAGE
#undef PG8_LDA
#undef PG8_LDB
#undef PG8_MMA
#undef PG8_WAIT_V
#undef PG8_WAIT_L
#undef PG8_BAR
#undef PG8_SCHED
}
}

using pg8::bf16_t; using pg8::bf16x8; using pg8::f32x4; using pg8::cvt_pk_bf16;
#define LAS __attribute__((address_space(3)))
typedef unsigned u32x2 __attribute__((ext_vector_type(2)));
typedef unsigned u32x4 __attribute__((ext_vector_type(4)));

constexpr int DM = 2048, MT = 8704, NZ = 7168, DFF = 5632, DFF2 = 11264, NCS = 136;
constexpr int LDS_BYTES = 131072;
#ifndef STOP_AFTER
#define STOP_AFTER 0
#endif

constexpr size_t SZ_WIN = 7168ull * 2048 * 2, SZ_WOUT = 2048ull * 2048 * 2, SZ_WCQ = 512ull * 2048 * 2, SZ_WCKV = 1024ull * 2048 * 2,
                 SZ_WCO = 2048ull * 512 * 2, SZ_WUP = 11264ull * 2048 * 2, SZ_WDN = 2048ull * 5632 * 2, SZ_WG = 8ull * 2048 * 4;
constexpr size_t OFF_WIN = 0, OFF_WOUT = OFF_WIN + SZ_WIN, OFF_WCQ = OFF_WOUT + SZ_WOUT, OFF_WCKV = OFF_WCQ + SZ_WCQ, OFF_WCO = OFF_WCKV + SZ_WCKV,
                 OFF_WUP = OFF_WCO + SZ_WCO, OFF_WDN = OFF_WUP + SZ_WUP, OFF_WG = OFF_WDN + SZ_WDN, SZ_LAYER = OFF_WG + SZ_WG;
constexpr size_t WS_X = 2 * SZ_LAYER;
constexpr size_t WS_H = WS_X + (size_t)MT * DM * 4;
constexpr size_t WS_HMEM = WS_H + (size_t)MT * DM * 2;
constexpr size_t WS_MKV = WS_HMEM + 2ull * 256 * 2048 * 2;
constexpr size_t WS_D = WS_MKV + 2ull * 256 * 1024 * 2;
constexpr size_t WS_Z = WS_D, WS_CD = WS_D + (size_t)MT * NZ * 2, WS_U = WS_D;
constexpr size_t WS_E = WS_D + (size_t)MT * DFF2 * 2;
constexpr size_t WS_MIX = WS_E, WS_QC = WS_E, WS_OC = WS_E + 16ull * 1024 * 1024, WS_ACT = WS_E;
constexpr size_t WS_S = WS_E + (size_t)MT * DFF * 2;
constexpr size_t WS_IG = WS_S, WS_LF = WS_IG + (size_t)MT * 4 * 4, WS_BL = WS_LF + (size_t)MT * 4 * 4, WS_GMAX = WS_BL + 4096, WS_MENT = WS_GMAX + 4096,
                 WS_DN = WS_MENT + 4096, WS_NENT = WS_DN + (size_t)NCS * 4 * 256 * 4, WS_BAR = WS_NENT + (size_t)NCS * 4 * 256 * 4, WS_END = WS_BAR + 256;
static_assert(WS_CD + (size_t)NCS * 4 * 65536 * 2 <= WS_E, "region D");

constexpr size_t O_YP = 0, O_YS = O_YP + 8192ull * 2048, O_PC = O_YS + 512ull * 2048, O_PN = O_PC + 2ull * 4 * 65536, O_PM = O_PN + 2 * 4 * 256,
                 O_PK = O_PM + 8, O_PV = O_PK + 2ull * 512 * 1024, O_PMK = O_PV + 2ull * 512 * 1024, O_PMV = O_PMK + 2ull * 256 * 512,
                 O_PCONV = O_PMV + 2ull * 256 * 512, O_SC = O_PCONV + 2ull * 2 * DFF2, O_SN = O_SC + 2ull * 8 * 4 * 65536, O_SM = O_SN + 2ull * 8 * 4 * 256,
                 O_SK = O_SM + 64, O_SV = O_SK + 2ull * 8 * 64 * 1024, O_SCONV = O_SV + 2ull * 8 * 64 * 1024, O_END = O_SCONV + 2ull * 8 * 2 * DFF2;

struct Params { const float* in[29]; float* out; unsigned char* ws; };
enum { I_XP = 0, I_XS, I_MEM, I_CAK, I_CAV, I_CMK, I_CMV, I_SC, I_SN, I_SM, I_SCONV, I_GMIX, I_WIN, I_BI, I_BF, I_GHEAD, I_REL, I_WOUT, I_GCROSS, I_GMEM, I_WCQ, I_WCKV,
       I_WCO, I_GFFN, I_WUP, I_CONVW, I_CONVB, I_WDN, I_GFINAL };

__device__ __forceinline__ int otid() { int t = threadIdx.x; asm volatile("" : "+v"(t)); return t; }
__device__ __forceinline__ int obid() { int t = blockIdx.x; asm volatile("" : "+s"(t)); return t; }
__device__ __forceinline__ unsigned short f2bf(float f) { unsigned u = __float_as_uint(f); u += 0x7FFFu + ((u >> 16) & 1u); return (unsigned short)(u >> 16); }
__device__ __forceinline__ float bflo(unsigned w) { return __uint_as_float(w << 16); }
__device__ __forceinline__ float bfhi(unsigned w) { return __uint_as_float(w & 0xffff0000u); }
__device__ __forceinline__ f32x4 mfma16(bf16x8 a, bf16x8 b, f32x4 c) { return __builtin_amdgcn_mfma_f32_16x16x32_bf16(a, b, c, 0, 0, 0); }
__device__ __forceinline__ u32x4 ld8(const void* p, size_t eoff, bool isf) {
    if (isf) { const float* f = (const float*)p + eoff; const f32x4 a = *(const f32x4*)f, b = *(const f32x4*)(f + 4);
        u32x4 w; w.x = cvt_pk_bf16(a[0], a[1]); w.y = cvt_pk_bf16(a[2], a[3]); w.z = cvt_pk_bf16(b[0], b[1]); w.w = cvt_pk_bf16(b[2], b[3]); return w; }
    return *(const u32x4*)((const bf16_t*)p + eoff);
}
__device__ __forceinline__ void st_tr8(LAS unsigned short* T, int ldt, int c8, int r, u32x4 w) {
    T[(c8 + 0) * ldt + r] = (unsigned short)(w.x & 0xffffu); T[(c8 + 1) * ldt + r] = (unsigned short)(w.x >> 16);
    T[(c8 + 2) * ldt + r] = (unsigned short)(w.y & 0xffffu); T[(c8 + 3) * ldt + r] = (unsigned short)(w.y >> 16);
    T[(c8 + 4) * ldt + r] = (unsigned short)(w.z & 0xffffu); T[(c8 + 5) * ldt + r] = (unsigned short)(w.z >> 16);
    T[(c8 + 6) * ldt + r] = (unsigned short)(w.w & 0xffffu); T[(c8 + 7) * ldt + r] = (unsigned short)(w.w >> 16);
}
__device__ __forceinline__ float wsum(float v) { v += __shfl_xor(v, 1); v += __shfl_xor(v, 2); v += __shfl_xor(v, 4); v += __shfl_xor(v, 8); v += __shfl_xor(v, 16); v += __shfl_xor(v, 32); return v; }

__device__ __forceinline__ void convw(LAS unsigned char* L, const float* __restrict__ src, int ld, int K, int N, bf16_t* __restrict__ dst, int skip) {
    LAS unsigned short* T = (LAS unsigned short*)L;
    const int tid = otid(), nkt = K >> 6, ntl = nkt * (N >> 6);
    for (int t = blockIdx.x; t < ntl; t += gridDim.x) {
        const int kt = t % nkt, nt = t / nkt, k0 = kt * 64, n0 = nt * 64, nsrc = n0 + ((skip && n0 >= 3072) ? 8 : 0);
        const int kk = tid >> 4, n4 = (tid & 15) * 4;
#pragma unroll
        for (int hf = 0; hf < 2; ++hf) { const int k = kk + hf * 32; const f32x4 v = *(const f32x4*)(src + (size_t)(k0 + k) * ld + nsrc + n4);
            T[(n4 + 0) * 72 + k] = f2bf(v[0]); T[(n4 + 1) * 72 + k] = f2bf(v[1]); T[(n4 + 2) * 72 + k] = f2bf(v[2]); T[(n4 + 3) * 72 + k] = f2bf(v[3]); }
        __syncthreads();
        { const int n = tid >> 3, k8 = (tid & 7) * 8; const u32x4 w = *(LAS u32x4*)(T + n * 72 + k8); *(u32x4*)(dst + (size_t)(n0 + n) * K + k0 + k8) = w; }
        __syncthreads();
    }
}

__device__ __forceinline__ void norm_phase(LAS unsigned char* L, const float* xp, const float* xs, float* X, const float* __restrict__ g, bf16_t* H, float* yout, int rows, int mode,
                                           const float* WG, const float* bi, const float* bfg, float* IG, float* LF) {
    const int tid = otid(), lane = tid & 63, wave = tid >> 6;
    LAS float* WGs = (LAS float*)L;
    if (mode & 2) { for (int i = tid; i < 8 * 2048; i += 512) WGs[i] = WG[i]; __syncthreads(); }
    for (int row = blockIdx.x * 8 + wave; row < rows; row += gridDim.x * 8) {
        const float* src = (mode & 1) ? (row < 8192 ? xp + (size_t)row * DM : xs + (size_t)(row - 8192) * DM) : X + (size_t)row * DM;
        f32x4 xv[8]; float ss = 0.f;
#pragma unroll
        for (int i = 0; i < 8; ++i) { xv[i] = *(const f32x4*)(src + i * 256 + lane * 4); ss += xv[i][0] * xv[i][0] + xv[i][1] * xv[i][1] + xv[i][2] * xv[i][2] + xv[i][3] * xv[i][3]; }
        ss = wsum(ss);
        const float r = rsqrtf(ss * (1.0f / 2048.0f) + 1e-6f);
        if (mode & 1) {
#pragma unroll
            for (int i = 0; i < 8; ++i) *(f32x4*)(X + (size_t)row * DM + i * 256 + lane * 4) = xv[i];
        }
#pragma unroll
        for (int i = 0; i < 8; ++i) { const f32x4 gv = *(const f32x4*)(g + i * 256 + lane * 4); xv[i] = xv[i] * r * gv;
            if (mode & 4) *(f32x4*)(yout + (size_t)row * DM + i * 256 + lane * 4) = xv[i];
            else { u32x2 w; w.x = cvt_pk_bf16(xv[i][0], xv[i][1]); w.y = cvt_pk_bf16(xv[i][2], xv[i][3]); *(u32x2*)(H + (size_t)row * DM + i * 256 + lane * 4) = w; } }
        if (mode & 2) {
            float z[8];
#pragma unroll
            for (int j = 0; j < 8; ++j) { float a = 0.f;
#pragma unroll
                for (int i = 0; i < 8; ++i) { const f32x4 wv = *(LAS f32x4*)(WGs + j * 2048 + i * 256 + lane * 4); a += xv[i][0] * wv[0] + xv[i][1] * wv[1] + xv[i][2] * wv[2] + xv[i][3] * wv[3]; }
                z[j] = wsum(a); asm volatile("" ::: "memory"); }
            if (lane == 0) {
#pragma unroll
                for (int j = 0; j < 4; ++j) { IG[row * 4 + j] = z[j] + bi[j]; const float f = z[4 + j] + bfg[j]; LF[row * 4 + j] = fminf(f, 0.f) - log1pf(__expf(-fabsf(f))); } }
        }
    }
    __syncthreads();
}

struct EpiRes {
    static constexpr bool PERM = false, AFTER_DRAIN = false;
    float* X;
    __device__ __forceinline__ void operator()(const f32x4 (&acc)[2][2][4][2], const pg8::Unit& u, int wr, int wc, int fr, int fq) const {
        const int row0 = u.pm * 256 + wr * 64 + fr, col0 = u.pn * 256 + wc * 32 + 4 * fq;
#pragma unroll
        for (int ai = 0; ai < 2; ++ai)
#pragma unroll
            for (int m = 0; m < 4; ++m) { float* rowp = X + (size_t)(row0 + ai * 128 + m * 16) * DM + col0;
#pragma unroll
                for (int bj = 0; bj < 2; ++bj)
#pragma unroll
                    for (int n = 0; n < 2; ++n) { f32x4* q = (f32x4*)(rowp + bj * 128 + n * 16); *q = *q + acc[ai][bj][m][n]; }
                asm volatile("" ::: "memory"); }
    }
};
struct EpiGen {
    static constexpr bool PERM = false, AFTER_DRAIN = false;
    bf16_t* O; int ldc; int mode; float* f0; float* f1; float* f2; float* f3;
    __device__ __forceinline__ void operator()(const f32x4 (&acc)[2][2][4][2], const pg8::Unit& u, int wr, int wc, int fr, int fq) const {
        const int row0 = u.pm * 256 + wr * 64 + fr, col0 = u.pn * 256 + wc * 32 + 4 * fq; const int blk = u.pn >> 2;
#pragma unroll
        for (int ai = 0; ai < 2; ++ai)
#pragma unroll
            for (int m = 0; m < 4; ++m) { const int row = row0 + ai * 128 + m * 16;
#pragma unroll
                for (int bj = 0; bj < 2; ++bj)
#pragma unroll
                    for (int n = 0; n < 2; ++n) { const int col = col0 + bj * 128 + n * 16; f32x4 v = acc[ai][bj][m][n];
                        if (mode == 1) { if (blk == 1) v = v * 0.0625f; else if (blk == 3) { v[0] = 1.0f / (1.0f + __expf(-v[0])); v[1] = 1.0f / (1.0f + __expf(-v[1])); v[2] = 1.0f / (1.0f + __expf(-v[2])); v[3] = 1.0f / (1.0f + __expf(-v[3])); } }
                        u32x2 w; w.x = cvt_pk_bf16(v[0], v[1]); w.y = cvt_pk_bf16(v[2], v[3]); *(u32x2*)(O + (size_t)row * ldc + col) = w;
                        if (mode == 1) { if (blk >= 5 && u.pm >= 30) { const int c = col - blk * 1024;
                                float* d = (u.pm < 32) ? ((blk == 5 ? f0 : f1) + (size_t)(row - 7680) * 1024 + c) : ((blk == 5 ? f2 : f3) + (size_t)(row - 8192) * 1024 + c); *(f32x4*)d = v; } }
                        else if (mode == 2) { float* d = (col < 512) ? (f0 + (size_t)row * 512 + col) : (f1 + (size_t)row * 512 + (col - 512)); *(f32x4*)d = v; }
                        else if (mode == 3) { if (row == 8190 || row == 8191) *(f32x4*)(f0 + (size_t)(row - 8190) * DFF2 + col) = v;
                            else if (row >= 8192) { const int rs = row - 8192, s = rs & 63; if (s >= 62) *(f32x4*)(f2 + (size_t)((rs >> 6) * 2 + (s - 62)) * DFF2 + col) = v; } }
                    } }
    }
};
template <class Epi> __device__ __forceinline__ void run_gemm(LAS unsigned char* L, const bf16_t* A, const bf16_t* Bt, int M, int N, int K, const Epi& E) {
    pg8::Gemm g{A, Bt, M, N, K}; pg8::StaticOrder S; S.init(M, N, (int)gridDim.x, (int)blockIdx.x);
    pg8::gemm_phase<Epi, pg8::StaticOrder, false>(L, g, S, E, nullptr);
    __syncthreads();
}

constexpr int AT_QS = 0, AT_KS = 17408, AT_VT = 34816, AT_PW = 53248, AT_BT = 63488, AT_CM = 65600, AT_CO = AT_CM + 512;
__device__ __forceinline__ void attn_unit(LAS unsigned char* L, int type, int l, int c  , int h, const bf16_t* Q, int ldq, const bf16_t* Z, const bf16_t* MKV,
                                          const float* ck, const float* cv, const float* bias, bf16_t* O, int ldo) {
    const int tid = otid(), lane = tid & 63, w = tid >> 6, qt = w & 3, kh = w >> 2, fr = lane & 15, fq = lane >> 4;
    const int ntile = (type < 2) ? 9 : 4, tile0 = (type == 0 && c < 8) ? 8 - c : 0;
    LAS float* bt = (LAS float*)(L + AT_BT);
    __syncthreads();
#pragma unroll
    for (int i = 0; i < 2; ++i) { const int idx = tid + i * 512, r = idx >> 4, c8 = (idx & 15) * 8; *(LAS u32x4*)(L + AT_QS + (r * 136 + c8) * 2) = *(const u32x4*)(Q + (size_t)r * ldq + c8); }
    if (bias) for (int i = tid; i < 513; i += 512) bt[i] = bias[i];
    __syncthreads();
    bf16x8 qf[4];
#pragma unroll
    for (int ks = 0; ks < 4; ++ks) qf[ks] = *(LAS bf16x8*)(L + AT_QS + ((qt * 16 + fr) * 136 + ks * 32 + fq * 8) * 2);
    float m_run = -1e30f, l_run = 0.f; f32x4 o[8];
#pragma unroll
    for (int i = 0; i < 8; ++i) o[i] = (f32x4){0.f, 0.f, 0.f, 0.f};
    const float scale = 0.08838834764831845f;
    for (int kt = tile0; kt < ntile; ++kt) {
        const void* kp; const void* vp; int ld; bool isf;
        if (type == 0) { const int cc = c - 8 + kt; kp = Z + (size_t)(cc * 64) * NZ + 5120 + h * 128; vp = (const bf16_t*)kp + 1024; ld = NZ; isf = false; }
        else if (type == 1) { if (kt < 8) { const size_t o_ = ((size_t)((l * 8 + c) * 512 + kt * 64)) * 1024 + h * 128; kp = ck + o_; vp = cv + o_; ld = 1024; isf = true; }
                              else { kp = Z + (size_t)(8192 + c * 64) * NZ + 5120 + h * 128; vp = (const bf16_t*)kp + 1024; ld = NZ; isf = false; } }
        else if (type == 2) { kp = MKV + (size_t)(kt * 64) * 1024 + h * 128; vp = (const bf16_t*)kp + 512; ld = 1024; isf = false; }
        else { const size_t o_ = ((size_t)((l * 8 + c) * 256 + kt * 64)) * 512 + h * 128; kp = ck + o_; vp = cv + o_; ld = 512; isf = true; }
        __syncthreads();
#pragma unroll
        for (int i = 0; i < 2; ++i) { const int idx = tid + i * 512, r = idx >> 4, c8 = (idx & 15) * 8;
            const u32x4 kw = ld8(kp, (size_t)r * ld + c8, isf); *(LAS u32x4*)(L + AT_KS + (r * 136 + c8) * 2) = kw;
            const u32x4 vw = ld8(vp, (size_t)r * ld + c8, isf); st_tr8((LAS unsigned short*)(L + AT_VT), 72, c8, r, vw); }
        __syncthreads();
        f32x4 s[2];
#pragma unroll
        for (int st = 0; st < 2; ++st) { s[st] = (f32x4){0.f, 0.f, 0.f, 0.f};
#pragma unroll
            for (int ks = 0; ks < 4; ++ks) { const bf16x8 kf = *(LAS bf16x8*)(L + AT_KS + ((kh * 32 + st * 16 + fr) * 136 + ks * 32 + fq * 8) * 2); s[st] = mfma16(kf, qf[ks], s[st]); } }
        float mx = -1e30f;
#pragma unroll
        for (int st = 0; st < 2; ++st)
#pragma unroll
            for (int j = 0; j < 4; ++j) { float v = s[st][j] * scale;
                if (bias) { int rel = 512 + (qt * 16 + fr) - (kt * 64 + kh * 32 + st * 16 + fq * 4 + j); rel = rel > 256 ? 256 : (rel < -256 ? -256 : rel); v += bt[rel + 256]; }
                s[st][j] = v; mx = fmaxf(mx, v); }
        mx = fmaxf(mx, __shfl_xor(mx, 16)); mx = fmaxf(mx, __shfl_xor(mx, 32));
        const float m_new = fmaxf(m_run, mx), alpha = __expf(m_run - m_new); m_run = m_new;
        float rs = 0.f;
#pragma unroll
        for (int st = 0; st < 2; ++st)
#pragma unroll
            for (int j = 0; j < 4; ++j) { const float pv = __expf(s[st][j] - m_new); s[st][j] = pv; rs += pv; }
        l_run = l_run * alpha + rs;
#pragma unroll
        for (int i = 0; i < 8; ++i) o[i] = o[i] * alpha;
        LAS unsigned char* pw = L + AT_PW + w * 1280;
#pragma unroll
        for (int st = 0; st < 2; ++st) { u32x2 pk; pk.x = cvt_pk_bf16(s[st][0], s[st][1]); pk.y = cvt_pk_bf16(s[st][2], s[st][3]); *(LAS u32x2*)(pw + (fr * 40 + st * 16 + fq * 4) * 2) = pk; }
        asm volatile("s_waitcnt lgkmcnt(0)" ::: "memory");
        const bf16x8 pf = *(LAS bf16x8*)(pw + (fr * 40 + fq * 8) * 2);
#pragma unroll
        for (int i = 0; i < 8; ++i) { const bf16x8 vf = *(LAS bf16x8*)(L + AT_VT + ((i * 16 + fr) * 72 + kh * 32 + fq * 8) * 2); o[i] = mfma16(vf, pf, o[i]); }
    }
    l_run += __shfl_xor(l_run, 16); l_run += __shfl_xor(l_run, 32);
    __syncthreads();
    LAS float* cm = (LAS float*)(L + AT_CM); LAS float* co = (LAS float*)(L + AT_CO);
    if (kh == 1) { if (fq == 0) { cm[qt * 16 + fr] = m_run; cm[64 + qt * 16 + fr] = l_run; }
#pragma unroll
        for (int i = 0; i < 8; ++i)
#pragma unroll
            for (int j = 0; j < 4; ++j) co[(qt * 128 + i * 16 + fq * 4 + j) * 16 + fr] = o[i][j]; }
    __syncthreads();
    if (kh == 0) { const float m1 = cm[qt * 16 + fr], l1 = cm[64 + qt * 16 + fr]; const float m = fmaxf(m_run, m1), a0 = __expf(m_run - m), a1 = __expf(m1 - m);
        const float inv = 1.0f / (l_run * a0 + l1 * a1);
#pragma unroll
        for (int i = 0; i < 8; ++i) { float r[4];
#pragma unroll
            for (int j = 0; j < 4; ++j) r[j] = (o[i][j] * a0 + co[(qt * 128 + i * 16 + fq * 4 + j) * 16 + fr] * a1) * inv;
            u32x2 pk; pk.x = cvt_pk_bf16(r[0], r[1]); pk.y = cvt_pk_bf16(r[2], r[3]); *(u32x2*)(O + (size_t)(qt * 16 + fr) * ldo + i * 16 + fq * 4) = pk; } }
}

constexpr int PA_VT = 0, PA_KT = 36864, PA_ES = 73728;
__device__ __forceinline__ void mlstm_pa(LAS unsigned char* L, int cs, int h, const bf16_t* Z, const float* IG, const float* LF, bf16_t* CD, float* DN, float* BL, float* GMAX) {
    const int tid = otid(), lane = tid & 63, w = tid >> 6, fr = lane & 15, fq = lane >> 4, row0 = cs * 64;
    LAS float* es = (LAS float*)(L + PA_ES);
    __syncthreads();
    if (w == 0) { float b = LF[(row0 + lane) * 4 + h]; const float ig = IG[(row0 + lane) * 4 + h];
#pragma unroll
        for (int off = 1; off < 64; off <<= 1) { const float v = __shfl_up(b, off); if (lane >= off) b += v; }
        const float bL = __shfl(b, 63); const float xg = ig - b; float mx = xg;
#pragma unroll
        for (int off = 1; off < 64; off <<= 1) mx = fmaxf(mx, __shfl_xor(mx, off));
        es[lane] = __expf(xg - mx);
        if (lane == 0) { BL[cs * 4 + h] = bL; GMAX[cs * 4 + h] = bL + mx; } }
    __syncthreads();
#pragma unroll
    for (int i = 0; i < 4; ++i) { const int idx = tid + i * 512, s = idx >> 5, c8 = (idx & 31) * 8; const float e = es[s];
        const u32x4 kw = *(const u32x4*)(Z + (size_t)(row0 + s) * NZ + 1024 + h * 256 + c8); st_tr8((LAS unsigned short*)(L + PA_KT), 72, c8, s, kw);
        u32x4 vw = *(const u32x4*)(Z + (size_t)(row0 + s) * NZ + 2048 + h * 256 + c8);
        vw.x = cvt_pk_bf16(bflo(vw.x) * e, bfhi(vw.x) * e); vw.y = cvt_pk_bf16(bflo(vw.y) * e, bfhi(vw.y) * e); vw.z = cvt_pk_bf16(bflo(vw.z) * e, bfhi(vw.z) * e); vw.w = cvt_pk_bf16(bflo(vw.w) * e, bfhi(vw.w) * e);
        st_tr8((LAS unsigned short*)(L + PA_VT), 72, c8, s, vw); }
    __syncthreads();
    bf16_t* Cd = CD + (size_t)(cs * 4 + h) * 65536;
#pragma unroll 1
    for (int vt = 0; vt < 2; ++vt) { const int vb = w * 32 + vt * 16;
        bf16x8 vf[2];
#pragma unroll
        for (int ks = 0; ks < 2; ++ks) vf[ks] = *(LAS bf16x8*)(L + PA_VT + ((vb + fr) * 72 + ks * 32 + fq * 8) * 2);
#pragma unroll
        for (int k2 = 0; k2 < 16; ++k2) { f32x4 a = (f32x4){0.f, 0.f, 0.f, 0.f};
#pragma unroll
            for (int ks = 0; ks < 2; ++ks) { const bf16x8 kf = *(LAS bf16x8*)(L + PA_KT + ((k2 * 16 + fr) * 72 + ks * 32 + fq * 8) * 2); a = mfma16(kf, vf[ks], a); }
            u32x2 pk; pk.x = cvt_pk_bf16(a[0], a[1]); pk.y = cvt_pk_bf16(a[2], a[3]); *(u32x2*)(Cd + (size_t)(vb + fr) * 256 + k2 * 16 + fq * 4) = pk; } }
    if (tid < 256) { float a = 0.f; LAS unsigned short* kT = (LAS unsigned short*)(L + PA_KT);
        for (int s = 0; s < 64; ++s) a += es[s] * __uint_as_float(((unsigned)kT[tid * 72 + s]) << 16);
        DN[(size_t)(cs * 4 + h) * 256 + tid] = a; }
}

__device__ __forceinline__ void mlstm_scan(LAS unsigned char* L, int l, const float* BL, const float* GMAX, float* MENT, bf16_t* CD, const float* DN, float* NENT,
                                           const float* sC, const float* sN, const float* sM, float* out) {
    const int tid = otid(); LAS float* As = (LAS float*)L; LAS float* Es = As + NCS * 4;
    __syncthreads();
    if (tid < 4) { const int h = tid; float m = 0.f;
        for (int c = 0; c < 128; ++c) { const float bL = BL[c * 4 + h], gm = GMAX[c * 4 + h], mn = fmaxf(bL + m, gm); As[c * 4 + h] = __expf(bL + m - mn); Es[c * 4 + h] = __expf(gm - mn);
            if (blockIdx.x == 0) MENT[c * 4 + h] = m; m = mn; }
        if (blockIdx.x == 0) out[O_PM + l * 4 + h] = m; }
    else if (tid < 36) { const int b = (tid - 4) >> 2, h = (tid - 4) & 3, cs = 128 + b; const float m = sM[(l * 8 + b) * 4 + h];
        const float bL = BL[cs * 4 + h], gm = GMAX[cs * 4 + h], mn = fmaxf(bL + m, gm); As[cs * 4 + h] = __expf(bL + m - mn); Es[cs * 4 + h] = __expf(gm - mn);
        if (blockIdx.x == 0) { MENT[cs * 4 + h] = m; out[O_SM + (l * 8 + b) * 4 + h] = mn; } }
    __syncthreads();
    const int gt = blockIdx.x * 512 + tid, nthr = gridDim.x * 512;
    for (int p = gt; p < 131072; p += nthr) { const int h = p >> 15, e2 = (p & 32767) * 2;
        float c0 = 0.f, c1 = 0.f; unsigned* base = (unsigned*)(CD + (size_t)h * 65536 + e2);
        for (int c = 0; c < 128; c += 8) { unsigned d[8];
#pragma unroll
            for (int i = 0; i < 8; ++i) d[i] = base[(size_t)(c + i) * (4 * 65536 / 2)];
#pragma unroll
            for (int i = 0; i < 8; ++i) { base[(size_t)(c + i) * (4 * 65536 / 2)] = cvt_pk_bf16(c0, c1); const float a = As[(c + i) * 4 + h], e = Es[(c + i) * 4 + h]; c0 = a * c0 + e * bflo(d[i]); c1 = a * c1 + e * bfhi(d[i]); } }
        *(float2*)(out + O_PC + (size_t)(l * 4 + h) * 65536 + e2) = make_float2(c0, c1);
        for (int b = 0; b < 8; ++b) { const int cs = 128 + b; const float2 ci = *(const float2*)(sC + (size_t)((l * 8 + b) * 4 + h) * 65536 + e2);
            unsigned* q = base + (size_t)cs * (4 * 65536 / 2); const unsigned d = *q; *q = cvt_pk_bf16(ci.x, ci.y); const float a = As[cs * 4 + h], e = Es[cs * 4 + h];
            *(float2*)(out + O_SC + (size_t)((l * 8 + b) * 4 + h) * 65536 + e2) = make_float2(a * ci.x + e * bflo(d), a * ci.y + e * bfhi(d)); } }
    if (gt < 1024) { const int h = gt >> 8, k = gt & 255; float n = 0.f;
        for (int c = 0; c < 128; ++c) { const float d = DN[(size_t)(c * 4 + h) * 256 + k]; NENT[(size_t)(c * 4 + h) * 256 + k] = n; n = As[c * 4 + h] * n + Es[c * 4 + h] * d; }
        out[O_PN + (l * 4 + h) * 256 + k] = n;
        for (int b = 0; b < 8; ++b) { const int cs = 128 + b; const float ni = sN[((l * 8 + b) * 4 + h) * 256 + k]; const float d = DN[(size_t)(cs * 4 + h) * 256 + k]; NENT[(size_t)(cs * 4 + h) * 256 + k] = ni;
            out[O_SN + ((l * 8 + b) * 4 + h) * 256 + k] = As[cs * 4 + h] * ni + Es[cs * 4 + h] * d; } }
}

constexpr int PC_QS = 0, PC_KS = 33792, PC_VT = 67584, PC_PS = 104448, PC_SC = 113664;
__device__ __forceinline__ void mlstm_pc(LAS unsigned char* L, int cs, int h, const bf16_t* Z, const float* IG, const float* LF, const bf16_t* CD, const float* NENT, const float* MENT,
                                         const float* ghead  , bf16_t* MIX) {
    const int tid = otid(), lane = tid & 63, w = tid >> 6, fr = lane & 15, fq = lane >> 4, row0 = cs * 64;
    LAS float* sc = (LAS float*)(L + PC_SC);
    LAS float* bcum = sc, *xgs = sc + 64, *mts = sc + 128, *wis = sc + 192, *dns = sc + 256, *psum = sc + 320, *hsq = sc + 576;
    __syncthreads();
    if (w == 0) { float b = LF[(row0 + lane) * 4 + h]; const float ig = IG[(row0 + lane) * 4 + h]; const float m = MENT[cs * 4 + h];
#pragma unroll
        for (int off = 1; off < 64; off <<= 1) { const float v = __shfl_up(b, off); if (lane >= off) b += v; }
        const float xg = ig - b; float pm = xg;
#pragma unroll
        for (int off = 1; off < 64; off <<= 1) { const float v = __shfl_up(pm, off); if (lane >= off) pm = fmaxf(pm, v); }
        const float Mx = fmaxf(m, pm); bcum[lane] = b; xgs[lane] = xg; mts[lane] = b + Mx; wis[lane] = __expf(m - Mx); }
#pragma unroll
    for (int i = 0; i < 4; ++i) { const int idx = tid + i * 512, s = idx >> 5, c8 = (idx & 31) * 8; const bf16_t* zr = Z + (size_t)(row0 + s) * NZ + h * 256 + c8;
        *(LAS u32x4*)(L + PC_QS + (s * 264 + c8) * 2) = *(const u32x4*)(zr);
        *(LAS u32x4*)(L + PC_KS + (s * 264 + c8) * 2) = *(const u32x4*)(zr + 1024);
        const u32x4 vw = *(const u32x4*)(zr + 2048); st_tr8((LAS unsigned short*)(L + PC_VT), 72, c8, s, vw); }
    __syncthreads();
    {
        const int st = w >> 1, tt0 = (w & 1) * 2; f32x4 sa[2] = {(f32x4){0.f, 0.f, 0.f, 0.f}, (f32x4){0.f, 0.f, 0.f, 0.f}};
#pragma unroll
        for (int ks = 0; ks < 8; ++ks) { const bf16x8 kf = *(LAS bf16x8*)(L + PC_KS + ((st * 16 + fr) * 264 + ks * 32 + fq * 8) * 2);
#pragma unroll
            for (int i = 0; i < 2; ++i) { const bf16x8 qf = *(LAS bf16x8*)(L + PC_QS + (((tt0 + i) * 16 + fr) * 264 + ks * 32 + fq * 8) * 2); sa[i] = mfma16(kf, qf, sa[i]); } }
#pragma unroll
        for (int i = 0; i < 2; ++i) { const int t = (tt0 + i) * 16 + fr; const float ut = bcum[t] - mts[t]; float pr[4]; float rp = 0.f;
#pragma unroll
            for (int j = 0; j < 4; ++j) { const int s = st * 16 + fq * 4 + j; const float v = (s <= t) ? __expf(ut + xgs[s]) * sa[i][j] : 0.f; pr[j] = v; rp += v; }
            u32x2 pk; pk.x = cvt_pk_bf16(pr[0], pr[1]); pk.y = cvt_pk_bf16(pr[2], pr[3]); *(LAS u32x2*)(L + PC_PS + (t * 72 + st * 16 + fq * 4) * 2) = pk;
            rp += __shfl_xor(rp, 16); rp += __shfl_xor(rp, 32); if (fq == 0) psum[st * 64 + t] = rp; }
        const int t = tid >> 3, part = tid & 7; const float* nv = NENT + (size_t)(cs * 4 + h) * 256 + part * 32; float a = 0.f;
        LAS unsigned short* qrow = (LAS unsigned short*)(L + PC_QS) + t * 264 + part * 32;
#pragma unroll 8
        for (int d = 0; d < 32; ++d) a += nv[d] * __uint_as_float(((unsigned)qrow[d]) << 16);
        a += __shfl_xor(a, 1); a += __shfl_xor(a, 2); a += __shfl_xor(a, 4); if (part == 0) dns[t] = a;
    }
    __syncthreads();
    const int v0 = w * 32; const bf16_t* Cg = CD + (size_t)(cs * 4 + h) * 65536;
    f32x4 acc[2][4];
#pragma unroll
    for (int vt = 0; vt < 2; ++vt)
#pragma unroll
        for (int tt = 0; tt < 4; ++tt) acc[vt][tt] = (f32x4){0.f, 0.f, 0.f, 0.f};
#pragma unroll
    for (int ks = 0; ks < 8; ++ks) { bf16x8 cf[2];
#pragma unroll
        for (int vt = 0; vt < 2; ++vt) cf[vt] = *(const bf16x8*)(Cg + (size_t)(v0 + vt * 16 + fr) * 256 + ks * 32 + fq * 8);
#pragma unroll
        for (int tt = 0; tt < 4; ++tt) { const bf16x8 qf = *(LAS bf16x8*)(L + PC_QS + ((tt * 16 + fr) * 264 + ks * 32 + fq * 8) * 2);
#pragma unroll
            for (int vt = 0; vt < 2; ++vt) acc[vt][tt] = mfma16(cf[vt], qf, acc[vt][tt]); } }
    float dd[4];
#pragma unroll
    for (int tt = 0; tt < 4; ++tt) { const int t = tt * 16 + fr; const float wi = wis[t];
        const float den = wi * dns[t] + ((psum[t] + psum[64 + t]) + (psum[128 + t] + psum[192 + t])); dd[tt] = 1.0f / fmaxf(fabsf(den), __expf(-mts[t]));
#pragma unroll
        for (int vt = 0; vt < 2; ++vt) acc[vt][tt] = acc[vt][tt] * wi; }
#pragma unroll
    for (int ks = 0; ks < 2; ++ks) { bf16x8 vf[2];
#pragma unroll
        for (int vt = 0; vt < 2; ++vt) vf[vt] = *(LAS bf16x8*)(L + PC_VT + ((v0 + vt * 16 + fr) * 72 + ks * 32 + fq * 8) * 2);
#pragma unroll
        for (int tt = 0; tt < 4; ++tt) { const bf16x8 pf = *(LAS bf16x8*)(L + PC_PS + ((tt * 16 + fr) * 72 + ks * 32 + fq * 8) * 2);
#pragma unroll
            for (int vt = 0; vt < 2; ++vt) acc[vt][tt] = mfma16(vf[vt], pf, acc[vt][tt]); } }
#pragma unroll
    for (int tt = 0; tt < 4; ++tt) { float q = 0.f;
#pragma unroll
        for (int vt = 0; vt < 2; ++vt) { acc[vt][tt] = acc[vt][tt] * dd[tt]; q += acc[vt][tt][0] * acc[vt][tt][0] + acc[vt][tt][1] * acc[vt][tt][1] + acc[vt][tt][2] * acc[vt][tt][2] + acc[vt][tt][3] * acc[vt][tt][3]; }
        q += __shfl_xor(q, 16); q += __shfl_xor(q, 32); if (fq == 0) hsq[w * 64 + tt * 16 + fr] = q; }
    __syncthreads();
#pragma unroll
    for (int tt = 0; tt < 4; ++tt) { const int t = tt * 16 + fr; float tot = 0.f;
#pragma unroll
        for (int ww = 0; ww < 8; ++ww) tot += hsq[ww * 64 + t];
        const float rn = rsqrtf(tot * (1.0f / 256.0f) + 1e-6f); const size_t row = (size_t)(row0 + t);
#pragma unroll
        for (int vt = 0; vt < 2; ++vt) { const int v = v0 + vt * 16 + fq * 4; const u32x2 ow = *(const u32x2*)(Z + row * NZ + 3072 + h * 256 + v); const f32x4 gh = *(const f32x4*)(ghead + h * 256 + v);
            const f32x4 hv = acc[vt][tt] * rn * gh; u32x2 pk; pk.x = cvt_pk_bf16(bflo(ow.x) * hv[0], bfhi(ow.x) * hv[1]); pk.y = cvt_pk_bf16(bflo(ow.y) * hv[2], bfhi(ow.y) * hv[3]);
            *(u32x2*)(MIX + row * DM + h * 256 + v) = pk; } }
}

__device__ __forceinline__ void conv_phase(int l, const bf16_t* U, const float* cw  , const float* cb, const float* sconv  , bf16_t* ACT) {
    const int gt = obid() * 512 + otid(), nthr = gridDim.x * 512;
    for (int task = gt; task < 272 * 704; task += nthr) { const int rr = task / 704, cgi = task - rr * 704, j0 = cgi * 8, r0 = rr * 32;
        float pa2[8], pa1[8], pb2[8], pb1[8];
        const bool seq_start = (r0 < 8192) ? (r0 == 0) : (((r0 - 8192) & 63) == 0);
        if (seq_start) {
            if (r0 == 0) {
#pragma unroll
                for (int i = 0; i < 8; ++i) { pa2[i] = 0.f; pa1[i] = 0.f; pb2[i] = 0.f; pb1[i] = 0.f; } }
            else { const int b = (r0 - 8192) >> 6; const float* s0 = sconv + (size_t)(b * 2) * DFF2; const float* s1 = s0 + DFF2;
#pragma unroll
                for (int i = 0; i < 8; ++i) { pa2[i] = s0[j0 + i]; pa1[i] = s1[j0 + i]; pb2[i] = s0[DFF + j0 + i]; pb1[i] = s1[DFF + j0 + i]; } } }
        else { const u32x4 a2 = *(const u32x4*)(U + (size_t)(r0 - 2) * DFF2 + j0), a1 = *(const u32x4*)(U + (size_t)(r0 - 1) * DFF2 + j0),
                           b2 = *(const u32x4*)(U + (size_t)(r0 - 2) * DFF2 + DFF + j0), b1 = *(const u32x4*)(U + (size_t)(r0 - 1) * DFF2 + DFF + j0);
            pa2[0] = bflo(a2.x); pa2[1] = bfhi(a2.x); pa2[2] = bflo(a2.y); pa2[3] = bfhi(a2.y); pa2[4] = bflo(a2.z); pa2[5] = bfhi(a2.z); pa2[6] = bflo(a2.w); pa2[7] = bfhi(a2.w);
            pa1[0] = bflo(a1.x); pa1[1] = bfhi(a1.x); pa1[2] = bflo(a1.y); pa1[3] = bfhi(a1.y); pa1[4] = bflo(a1.z); pa1[5] = bfhi(a1.z); pa1[6] = bflo(a1.w); pa1[7] = bfhi(a1.w);
            pb2[0] = bflo(b2.x); pb2[1] = bfhi(b2.x); pb2[2] = bflo(b2.y); pb2[3] = bfhi(b2.y); pb2[4] = bflo(b2.z); pb2[5] = bfhi(b2.z); pb2[6] = bflo(b2.w); pb2[7] = bfhi(b2.w);
            pb1[0] = bflo(b1.x); pb1[1] = bfhi(b1.x); pb1[2] = bflo(b1.y); pb1[3] = bfhi(b1.y); pb1[4] = bflo(b1.z); pb1[5] = bfhi(b1.z); pb1[6] = bflo(b1.w); pb1[7] = bfhi(b1.w); }
        float wa0[8], wa1[8], wa2[8], ba[8], wb0[8], wb1[8], wb2[8], bb[8];
#pragma unroll
        for (int i = 0; i < 8; ++i) { wa0[i] = cw[j0 + i]; wa1[i] = cw[DFF2 + j0 + i]; wa2[i] = cw[2 * DFF2 + j0 + i]; ba[i] = cb[j0 + i];
            wb0[i] = cw[DFF + j0 + i]; wb1[i] = cw[DFF2 + DFF + j0 + i]; wb2[i] = cw[2 * DFF2 + DFF + j0 + i]; bb[i] = cb[DFF + j0 + i]; }
        for (int r = 0; r < 32; ++r) { const size_t row = (size_t)(r0 + r);
            const u32x4 ua = *(const u32x4*)(U + row * DFF2 + j0), ub = *(const u32x4*)(U + row * DFF2 + DFF + j0);
            float ca[8], cbv[8];
            ca[0] = bflo(ua.x); ca[1] = bfhi(ua.x); ca[2] = bflo(ua.y); ca[3] = bfhi(ua.y); ca[4] = bflo(ua.z); ca[5] = bfhi(ua.z); ca[6] = bflo(ua.w); ca[7] = bfhi(ua.w);
            cbv[0] = bflo(ub.x); cbv[1] = bfhi(ub.x); cbv[2] = bflo(ub.y); cbv[3] = bfhi(ub.y); cbv[4] = bflo(ub.z); cbv[5] = bfhi(ub.z); cbv[6] = bflo(ub.w); cbv[7] = bfhi(ub.w);
            float res[8];
#pragma unroll
            for (int i = 0; i < 8; ++i) { const float a = ba[i] + wa0[i] * pa2[i] + wa1[i] * pa1[i] + wa2[i] * ca[i]; const float b = bb[i] + wb0[i] * pb2[i] + wb1[i] * pb1[i] + wb2[i] * cbv[i];
                res[i] = a / (1.0f + __expf(-a)) * b; pa2[i] = pa1[i]; pa1[i] = ca[i]; pb2[i] = pb1[i]; pb1[i] = cbv[i]; }
            u32x4 o; o.x = cvt_pk_bf16(res[0], res[1]); o.y = cvt_pk_bf16(res[2], res[3]); o.z = cvt_pk_bf16(res[4], res[5]); o.w = cvt_pk_bf16(res[6], res[7]);
            *(u32x4*)(ACT + row * DFF + j0) = o; } }
}


__device__ __forceinline__ void gbar(unsigned* ctr, unsigned& target) {
    __builtin_amdgcn_fence(__ATOMIC_RELEASE, "agent");
    __syncthreads();
    target += gridDim.x;
    if (threadIdx.x == 0) {
        __hip_atomic_fetch_add(ctr, 1u, __ATOMIC_RELAXED, __HIP_MEMORY_SCOPE_AGENT);
        while (__hip_atomic_load(ctr, __ATOMIC_RELAXED, __HIP_MEMORY_SCOPE_AGENT) < target) __builtin_amdgcn_s_sleep(1);
    }
    __syncthreads();
    __builtin_amdgcn_fence(__ATOMIC_ACQUIRE, "agent");
}
__global__ void __launch_bounds__(512, 2) mega(Params p) {
    extern __shared__ __attribute__((aligned(16))) unsigned char lds_raw[];
    LAS unsigned char* L = (LAS unsigned char*)lds_raw;
    cg::grid_group grid = cg::this_grid();
    unsigned* bar_ctr = (unsigned*)(p.ws + WS_BAR); unsigned bar_target = 0;
    grid.sync();
#define GSYNC() gbar(bar_ctr, bar_target)
    unsigned char* ws = p.ws; float* out = p.out;
    float* X = (float*)(ws + WS_X); bf16_t* H = (bf16_t*)(ws + WS_H); bf16_t* Z = (bf16_t*)(ws + WS_Z); bf16_t* CD = (bf16_t*)(ws + WS_CD); bf16_t* U = (bf16_t*)(ws + WS_U);
    bf16_t* MIX = (bf16_t*)(ws + WS_MIX); bf16_t* QC = (bf16_t*)(ws + WS_QC); bf16_t* OC = (bf16_t*)(ws + WS_OC); bf16_t* ACT = (bf16_t*)(ws + WS_ACT);
    float* IG = (float*)(ws + WS_IG); float* LF = (float*)(ws + WS_LF); float* BL = (float*)(ws + WS_BL); float* GMAX = (float*)(ws + WS_GMAX); float* MENT = (float*)(ws + WS_MENT);
    float* DN = (float*)(ws + WS_DN); float* NENT = (float*)(ws + WS_NENT);

#if STOP_AFTER != 0
    for (size_t i = (size_t)blockIdx.x * 512 + threadIdx.x; i < O_END; i += (size_t)gridDim.x * 512) out[i] = 0.f;
#endif
    for (int l = 0; l < 2; ++l) { unsigned char* wl = ws + (size_t)l * SZ_LAYER;
        convw(L, p.in[I_WIN] + (size_t)l * 2048 * 7176, 7176, 2048, 7168, (bf16_t*)(wl + OFF_WIN), 1);
        convw(L, p.in[I_WOUT] + (size_t)l * 2048 * 2048, 2048, 2048, 2048, (bf16_t*)(wl + OFF_WOUT), 0);
        convw(L, p.in[I_WCQ] + (size_t)l * 2048 * 512, 512, 2048, 512, (bf16_t*)(wl + OFF_WCQ), 0);
        convw(L, p.in[I_WCKV] + (size_t)l * 2048 * 1024, 1024, 2048, 1024, (bf16_t*)(wl + OFF_WCKV), 0);
        convw(L, p.in[I_WCO] + (size_t)l * 512 * 2048, 2048, 512, 2048, (bf16_t*)(wl + OFF_WCO), 0);
        convw(L, p.in[I_WUP] + (size_t)l * 2048 * DFF2, DFF2, 2048, DFF2, (bf16_t*)(wl + OFF_WUP), 0);
        convw(L, p.in[I_WDN] + (size_t)l * DFF * 2048, 2048, DFF, 2048, (bf16_t*)(wl + OFF_WDN), 0);
        float* WG = (float*)(wl + OFF_WG); const float* win = p.in[I_WIN] + (size_t)l * 2048 * 7176;
        for (int i = blockIdx.x * 512 + threadIdx.x; i < 8 * 2048; i += gridDim.x * 512) { const int j = i >> 11, k = i & 2047; WG[i] = win[(size_t)k * 7176 + 3072 + j]; }
        norm_phase(L, nullptr, nullptr, (float*)p.in[I_MEM], p.in[I_GMEM] + l * DM, (bf16_t*)(ws + WS_HMEM) + (size_t)l * 256 * 2048, nullptr, 256, 0, nullptr, nullptr, nullptr, nullptr, nullptr);
    }
    GSYNC();
#if STOP_AFTER == 1
        return;
#endif
    for (int l = 0; l < 2; ++l) {
        EpiGen E{(bf16_t*)(ws + WS_MKV) + (size_t)l * 256 * 1024, 1024, 2, out + O_PMK + (size_t)l * 256 * 512, out + O_PMV + (size_t)l * 256 * 512, nullptr, nullptr};
        run_gemm(L, (const bf16_t*)(ws + WS_HMEM) + (size_t)l * 256 * 2048, (const bf16_t*)(ws + (size_t)l * SZ_LAYER + OFF_WCKV), 256, 1024, 2048, E);
    }
    for (int l = 0; l < 2; ++l) {
        unsigned char* wl = ws + (size_t)l * SZ_LAYER;
        norm_phase(L, p.in[I_XP], p.in[I_XS], X, p.in[I_GMIX] + l * DM, H, nullptr, MT, (l == 0 ? 1 : 0) | 2, (const float*)(wl + OFF_WG), p.in[I_BI] + l * 4, p.in[I_BF] + l * 4, IG, LF);
        GSYNC();
#if STOP_AFTER == 2
        return;
#endif
        { EpiGen E{Z, NZ, 1, out + O_PK + (size_t)l * 512 * 1024, out + O_PV + (size_t)l * 512 * 1024, out + O_SK + (size_t)l * 512 * 1024, out + O_SV + (size_t)l * 512 * 1024};
          run_gemm(L, H, (const bf16_t*)(wl + OFF_WIN), MT, NZ, 2048, E); }
        GSYNC();
#if STOP_AFTER == 3
#ifdef DUMP3
        { const size_t gt_ = (size_t)blockIdx.x * 512 + threadIdx.x, nt_ = (size_t)gridDim.x * 512;
          for (size_t i = gt_; i < 34816; i += nt_) { out[i] = IG[i]; out[40000 + i] = LF[i]; }
          for (size_t i = gt_; i < 15000000; i += nt_) out[100000 + i] = __uint_as_float(((unsigned)Z[4 * i + (i & 3)]) << 16); }
#endif
        return;
#endif
        for (int u = blockIdx.x; u < NCS * 4; u += gridDim.x) mlstm_pa(L, u >> 2, u & 3, Z, IG, LF, CD, DN, BL, GMAX);
        for (int u = blockIdx.x; u < 1088; u += gridDim.x) {
            if (u < 1024) { const int c = u >> 3, h = u & 7; attn_unit(L, 0, l, c, h, Z + (size_t)(c * 64) * NZ + 4096 + h * 128, NZ, Z, nullptr, nullptr, nullptr, p.in[I_REL] + (size_t)(l * 8 + h) * 513, MIX + (size_t)(c * 64) * DM + 1024 + h * 128, DM); }
            else { const int b = (u - 1024) >> 3, h = u & 7; attn_unit(L, 1, l, b, h, Z + (size_t)(8192 + b * 64) * NZ + 4096 + h * 128, NZ, Z, nullptr, p.in[I_CAK], p.in[I_CAV], p.in[I_REL] + (size_t)(l * 8 + h) * 513, MIX + (size_t)(8192 + b * 64) * DM + 1024 + h * 128, DM); }
        }
        GSYNC();
#if STOP_AFTER == 4
#ifdef DUMP4
        { const size_t gt_ = (size_t)blockIdx.x * 512 + threadIdx.x, nt_ = (size_t)gridDim.x * 512;
          for (size_t i = gt_; i < 544; i += nt_) { out[i] = BL[i]; out[1000 + i] = GMAX[i]; }
#if DUMP4 == 1
          for (size_t i = gt_; i < 544 * 256; i += nt_) out[2000 + i] = DN[i];
#endif
#if DUMP4 == 2
          for (size_t i = gt_; i < 15000000; i += nt_) out[200000 + i] = __uint_as_float(((unsigned)CD[2 * i + (i & 1)]) << 16);
#endif
        }
#endif
        return;
#endif
        mlstm_scan(L, l, BL, GMAX, MENT, CD, DN, NENT, p.in[I_SC], p.in[I_SN], p.in[I_SM], out);
        GSYNC();
#if STOP_AFTER == 5
        return;
#endif
        for (int u = blockIdx.x; u < NCS * 4; u += gridDim.x) mlstm_pc(L, u >> 2, u & 3, Z, IG, LF, CD, NENT, MENT, p.in[I_GHEAD] + l * 1024, MIX);
        GSYNC();
#if STOP_AFTER == 6
        return;
#endif
        { EpiRes E{X}; run_gemm(L, MIX, (const bf16_t*)(wl + OFF_WOUT), MT, 2048, 2048, E); }
        GSYNC();
#if STOP_AFTER == 7
        return;
#endif
        norm_phase(L, nullptr, nullptr, X, p.in[I_GCROSS] + l * DM, H, nullptr, MT, 0, nullptr, nullptr, nullptr, nullptr, nullptr);
        GSYNC();
#if STOP_AFTER == 8
        return;
#endif
        { EpiGen E{QC, 512, 0, nullptr, nullptr, nullptr, nullptr}; run_gemm(L, H, (const bf16_t*)(wl + OFF_WCQ), MT, 512, 2048, E); }
        GSYNC();
#if STOP_AFTER == 9
        return;
#endif
        for (int u = blockIdx.x; u < NCS * 4; u += gridDim.x) { const int cr = u >> 2, h = u & 3;
            if (cr < 128) attn_unit(L, 2, l, cr, h, QC + (size_t)(cr * 64) * 512 + h * 128, 512, nullptr, (const bf16_t*)(ws + WS_MKV) + (size_t)l * 256 * 1024, nullptr, nullptr, nullptr, OC + (size_t)(cr * 64) * 512 + h * 128, 512);
            else attn_unit(L, 3, l, cr - 128, h, QC + (size_t)(cr * 64) * 512 + h * 128, 512, nullptr, nullptr, p.in[I_CMK], p.in[I_CMV], nullptr, OC + (size_t)(cr * 64) * 512 + h * 128, 512); }
        GSYNC();
#if STOP_AFTER == 10
        return;
#endif
        { EpiRes E{X}; run_gemm(L, OC, (const bf16_t*)(wl + OFF_WCO), MT, 2048, 512, E); }
        GSYNC();
#if STOP_AFTER == 11
        return;
#endif
        norm_phase(L, nullptr, nullptr, X, p.in[I_GFFN] + l * DM, H, nullptr, MT, 0, nullptr, nullptr, nullptr, nullptr, nullptr);
        GSYNC();
#if STOP_AFTER == 12
        return;
#endif
        { EpiGen E{U, DFF2, 3, out + O_PCONV + (size_t)l * 2 * DFF2, nullptr, out + O_SCONV + (size_t)l * 16 * DFF2, nullptr}; run_gemm(L, H, (const bf16_t*)(wl + OFF_WUP), MT, DFF2, 2048, E); }
        GSYNC();
#if STOP_AFTER == 13
        return;
#endif
        conv_phase(l, U, p.in[I_CONVW] + (size_t)l * 3 * DFF2, p.in[I_CONVB] + (size_t)l * DFF2, p.in[I_SCONV] + (size_t)l * 16 * DFF2, ACT);
        GSYNC();
#if STOP_AFTER == 14
        return;
#endif
        { EpiRes E{X}; run_gemm(L, ACT, (const bf16_t*)(wl + OFF_WDN), MT, 2048, DFF, E); }
        GSYNC();
#if STOP_AFTER == 15
        return;
#endif
    }
    norm_phase(L, nullptr, nullptr, X, p.in[I_GFINAL], nullptr, out, MT, 4, nullptr, nullptr, nullptr, nullptr, nullptr);
}

extern "C" void kernel_launch(void* const* d_in, const int* in_sizes, int n_in, void* d_out, int out_size, void* d_ws, size_t ws_size, hipStream_t stream) {
    static int grid_blocks = 0;
    if (grid_blocks == 0) {
        if (n_in != 29 || (size_t)out_size != O_END || ws_size < WS_END) { fprintf(stderr, "kernel_launch: unexpected sizes n_in %d out %d ws %zu (need %zu)\n", n_in, out_size, ws_size, (size_t)WS_END); grid_blocks = -1; return; }
        int dev = 0, cus = 0, per_cu = 0;
        hipGetDevice(&dev); hipDeviceGetAttribute(&cus, hipDeviceAttributeMultiprocessorCount, dev);
        hipFuncSetAttribute((const void*)mega, hipFuncAttributeMaxDynamicSharedMemorySize, LDS_BYTES);
        hipOccupancyMaxActiveBlocksPerMultiprocessor(&per_cu, (const void*)mega, 512, LDS_BYTES);
        if (per_cu < 1) { fprintf(stderr, "kernel_launch: occupancy query says %d blocks per CU\n", per_cu); per_cu = 1; }
        (void)hipGetLastError();
        grid_blocks = cus;
    }
    if (grid_blocks < 0) return;
    if (hipMemsetAsync((char*)d_ws + WS_BAR, 0, 256, stream) != hipSuccess) return;
    Params p{};
    for (int i = 0; i < 29; ++i) p.in[i] = (const float*)d_in[i];
    p.out = (float*)d_out; p.ws = (unsigned char*)d_ws;
    void* args[] = {&p};
    hipError_t e = hipLaunchCooperativeKernel((const void*)mega, dim3(grid_blocks), dim3(512), args, LDS_BYTES, stream);
    if (e != hipSuccess) fprintf(stderr, "cooperative launch failed: %s (grid %d)\n", hipGetErrorString(e), grid_blocks);
}
```

```cpp
#include <hip/hip_runtime.h>
#include <hip/hip_cooperative_groups.h>
#include <cstdio>
namespace cg = cooperative_groups;

namespace pg8 {
#define PG8_LAS __attribute__((address_space(3)))
typedef unsigned short bf16_t;
typedef short bf16x8 __attribute__((ext_vector_type(8)));
typedef float f32x4 __attribute__((ext_vector_type(4)));
typedef unsigned u32x4 __attribute__((ext_vector_type(4)));
constexpr int BM = 256, BK = 64, HALF = 128, HTB = HALF * BK * 2  , STAGE_BYTES = 8 * HTB, NXCD = 8, WGM = 8;

__host__ __device__ __forceinline__ int lds_byte(int r, int c) { const int st = (r >> 4) * 2 + (c >> 5), rr = r & 15, cc = c & 31, ob = rr * 64 + cc * 2; return st * 1024 + (ob ^ (((ob >> 9) & 1) << 5)); }
__host__ __device__ __forceinline__ void stage_rc(int b, int& R, int& C) { const int st = b / 1024, sb = b % 1024, swz = sb ^ (((sb >> 9) & 1) << 5); R = (st >> 1) * 16 + swz / 64; C = (st & 1) * 32 + (swz % 64) / 2; }
__host__ __device__ __forceinline__ int perm32(int rho) { const int n = rho >> 4, i = rho & 15; return 8 * (i >> 2) + 4 * n + (i & 3); }

struct Unit { int pm, pn, kc, slot; };
struct Gemm { const bf16_t* A; const bf16_t* Bt; int M, N, K, ldk; };

struct StaticOrder {
    int nM, nN, nwg, G, c, lim, S;
    __host__ __device__ __forceinline__ void init(int M, int N, int G_, int c_) { nM = M / BM; nN = N / BM; nwg = nM * nN; G = G_; c = c_; lim = nwg; S = 0; }
    __host__ __device__ __forceinline__ void map(int wgid, Unit& u) const { { const int q = nwg / NXCD, r = nwg % NXCD, xcd = wgid % NXCD, off = wgid / NXCD; wgid = (xcd < r ? xcd * (q + 1) : r * (q + 1) + (xcd - r) * q) + off; }
        const int nig = WGM * nN, gid = wgid / nig, fm = gid * WGM, gsz = (nM - fm) < WGM ? (nM - fm) : WGM;
        u.pm = fm + ((wgid % nig) % gsz); u.pn = (wgid % nig) / gsz; }
    __host__ __device__ __forceinline__ bool next(int i, Unit& u) const {
        if (S > 0) { const int nt_ = nwg - lim; if (i > 0 || c >= nt_ * S) return false; map(lim + (c % nt_), u); u.kc = c / nt_; u.slot = c % nt_; return true; }
        const long L = (long)i * G + c; if (L >= lim) return false; u.kc = 0; u.slot = 0;
        int wgid = (int)L; { const int q = nwg / NXCD, r = nwg % NXCD, xcd = wgid % NXCD, off = wgid / NXCD; wgid = (xcd < r ? xcd * (q + 1) : r * (q + 1) + (xcd - r) * q) + off; }
        const int nig = WGM * nN, gid = wgid / nig, fm = gid * WGM, gsz = (nM - fm) < WGM ? (nM - fm) : WGM;
        u.pm = fm + ((wgid % nig) % gsz); u.pn = (wgid % nig) / gsz; return true;
    }
    __device__ __forceinline__ void a_ready(const Unit&) const {}
    __device__ __forceinline__ void done(const Unit&) const {}
};
typedef __bf16 bf16v2_t __attribute__((ext_vector_type(2)));
__device__ __forceinline__ unsigned cvt_pk_bf16(float lo, float hi) { bf16v2_t v; v[0] = (__bf16)lo; v[1] = (__bf16)hi; return __builtin_bit_cast(unsigned, v); }
template <class Epi, class Sched, bool STAMP = false>
__device__ __forceinline__ void gemm_phase(PG8_LAS unsigned char* lds, const Gemm g, const Sched& S, const Epi& E, unsigned long long* stamps) {
    int tid_ = threadIdx.x; asm volatile("" : "+v"(tid_)); const int tid = tid_, wid = __builtin_amdgcn_readfirstlane(tid >> 6), lane = tid & 63, wr = wid >> 2, wc = wid & 3, fr = lane & 15, fq = lane >> 4;
    const int K = g.ldk, nt = g.K / BK; const size_t kcb = (size_t)g.K * 2;
    int ts_lo = 0, ts_hi = 0, nts = 0; const unsigned long long rt_entry = STAMP ? (unsigned long long)wall_clock64() : 0ull;
#define PG8_STAMP() do { if (STAMP && wid == 0 && nts < 64) { const unsigned long long _c = (unsigned long long)clock64(); \
        ts_lo = (lane == nts) ? (int)(unsigned)_c : ts_lo; ts_hi = (lane == nts) ? (int)(unsigned)(_c >> 32) : ts_hi; ++nts; } } while (0)
    PG8_STAMP();
    unsigned voffA[2], voffB[2];
#pragma unroll
    for (int i = 0; i < 2; ++i) { int R, C; stage_rc(tid * 16 + i * 8192, R, C); const int Rb = Epi::PERM ? ((R & ~31) + perm32(R & 31)) : R;
        voffA[i] = (unsigned)(R * K + C) * 2u; voffB[i] = (unsigned)(Rb * K + C) * 2u; }
    const size_t kstep = (size_t)(BK * 2);
    const size_t hstep = (size_t)HALF * K * 2;
    const size_t tstep = 2 * hstep;
    const unsigned ldsw = (unsigned)wid * 1024u;
    const int aoff = lds_byte(wr * 64 + fr, fq * 8), boff = lds_byte(wc * 32 + fr, fq * 8);
#define PG8_SA(b, h) (((b) * 2 + (h)) * HTB)
#define PG8_SB(b, h) ((4 + (b) * 2 + (h)) * HTB)
#define PG8_STAGE(bufoff, gbase, voff) do { _Pragma("unroll") for (int _i = 0; _i < 2; ++_i) \
        __builtin_amdgcn_global_load_lds((const unsigned*)((const char*)(gbase) + (voff)[_i]), (PG8_LAS unsigned*)(lds + (bufoff) + ldsw + _i * 8192), 16, 0, 0); } while (0)
#define PG8_LDA(dst, b, h) do { _Pragma("unroll") for (int m = 0; m < 4; ++m) _Pragma("unroll") for (int k = 0; k < 2; ++k) dst[m][k] = *(const PG8_LAS bf16x8*)(lds + PG8_SA(b, h) + aoff + m * 2048 + k * 1024); } while (0)
#define PG8_LDB(dst, b, h) do { _Pragma("unroll") for (int n = 0; n < 2; ++n) _Pragma("unroll") for (int k = 0; k < 2; ++k) dst[n][k] = *(const PG8_LAS bf16x8*)(lds + PG8_SB(b, h) + boff + n * 2048 + k * 1024); } while (0)
#define PG8_MMA(ai, bj, At, Bt) do { __builtin_amdgcn_s_setprio(1); _Pragma("unroll") for (int m = 0; m < 4; ++m) _Pragma("unroll") for (int n = 0; n < 2; ++n) _Pragma("unroll") for (int k = 0; k < 2; ++k) \
        acc[ai][bj][m][n] = __builtin_amdgcn_mfma_f32_16x16x32_bf16(Bt[n][k], At[m][k], acc[ai][bj][m][n], 0, 0, 0); __builtin_amdgcn_s_setprio(0); } while (0)
#define PG8_WAIT_V(n) asm volatile("s_waitcnt vmcnt(" #n ")" ::: "memory")
#define PG8_WAIT_L(n) asm volatile("s_waitcnt lgkmcnt(" #n ")" ::: "memory")
#define PG8_BAR __builtin_amdgcn_s_barrier()
#define PG8_SCHED __builtin_amdgcn_sched_barrier(0)
    Unit cur, nxt; int ui = 0;
    if (!S.next(0, cur)) return;
    f32x4 acc[2][2][4][2];
#pragma unroll
    for (int a = 0; a < 2; ++a)
#pragma unroll
        for (int b = 0; b < 2; ++b)
#pragma unroll
            for (int m = 0; m < 4; ++m)
#pragma unroll
                for (int n = 0; n < 2; ++n) acc[a][b][m][n] = (f32x4){0.f, 0.f, 0.f, 0.f};
    bf16x8 At[4][2], B0[2][2], B1[2][2];
    const char* cA = (const char*)g.A + (size_t)cur.pm * tstep + (size_t)cur.kc * kcb; const char* cB = (const char*)g.Bt + (size_t)cur.pn * tstep + (size_t)cur.kc * kcb;
    S.a_ready(cur);
    PG8_STAGE(PG8_SB(0, 0), cB, voffB); PG8_STAGE(PG8_SB(0, 1), cB + hstep, voffB); PG8_STAGE(PG8_SA(0, 0), cA, voffA); PG8_STAGE(PG8_SA(0, 1), cA + hstep, voffA);
    if (wr == 1) PG8_BAR;
    PG8_WAIT_V(2); PG8_BAR;
    PG8_STAGE(PG8_SB(1, 0), cB + kstep, voffB); PG8_STAGE(PG8_SA(1, 0), cA + kstep, voffA); PG8_STAGE(PG8_SB(1, 1), cB + hstep + kstep, voffB);
    PG8_WAIT_V(6); PG8_BAR;
    PG8_STAMP();
    for (;;) {
        const bool has_next = S.next(ui + 1, nxt);
        const char* nA = has_next ? (const char*)g.A + (size_t)nxt.pm * tstep + (size_t)nxt.kc * kcb : cA; const char* nB = has_next ? (const char*)g.Bt + (size_t)nxt.pn * tstep + (size_t)nxt.kc * kcb : cB;
        for (int t = 0; t < nt; t += 2) {
            const bool last = (t == nt - 2);
            const char* a1 = cA + (size_t)(t + 1) * kstep;
            const char* a2 = last ? nA : cA + (size_t)(t + 2) * kstep; const char* b2 = last ? nB : cB + (size_t)(t + 2) * kstep;
            const char* a3 = a2 + kstep; const char* b3 = b2 + kstep;
            if (last && has_next) S.a_ready(nxt);
            PG8_LDB(B0, 0, 0); PG8_LDB(B1, 0, 1); PG8_SCHED; PG8_LDA(At, 0, 0); PG8_STAGE(PG8_SA(1, 1), a1 + hstep, voffA);
            PG8_WAIT_V(8); PG8_WAIT_L(0); PG8_BAR; PG8_MMA(0, 0, At, B0); PG8_MMA(0, 1, At, B1); PG8_BAR; PG8_SCHED;
            PG8_LDA(At, 0, 1); PG8_STAGE(PG8_SB(0, 0), b2, voffB); PG8_STAGE(PG8_SB(0, 1), b2 + hstep, voffB); PG8_STAGE(PG8_SA(0, 0), a2, voffA);
            PG8_WAIT_V(8); PG8_WAIT_L(0); PG8_BAR; PG8_MMA(1, 0, At, B0); PG8_MMA(1, 1, At, B1); PG8_BAR; PG8_SCHED;
            PG8_LDB(B0, 1, 0); PG8_LDB(B1, 1, 1); PG8_SCHED; PG8_LDA(At, 1, 0); PG8_STAGE(PG8_SA(0, 1), a2 + hstep, voffA);
            PG8_WAIT_V(8); PG8_WAIT_L(0); PG8_BAR; PG8_MMA(0, 0, At, B0); PG8_MMA(0, 1, At, B1); PG8_BAR; PG8_SCHED;
            PG8_LDA(At, 1, 1); PG8_STAGE(PG8_SB(1, 0), b3, voffB); PG8_STAGE(PG8_SB(1, 1), b3 + hstep, voffB); PG8_STAGE(PG8_SA(1, 0), a3, voffA);
            PG8_WAIT_V(8); PG8_WAIT_L(0); PG8_BAR; PG8_MMA(1, 0, At, B0); PG8_MMA(1, 1, At, B1); PG8_BAR; PG8_SCHED;
        }
        PG8_STAMP();
        if (wr == 0) PG8_BAR;
        if constexpr (!Epi::AFTER_DRAIN) { E(acc, cur, wr, wc, fr, fq); S.done(cur); }
        PG8_STAMP();
        if (!has_next) break;
#pragma unroll
        for (int a = 0; a < 2; ++a)
#pragma unroll
            for (int b = 0; b < 2; ++b)
#pragma unroll
                for (int m = 0; m < 4; ++m)
#pragma unroll
                    for (int n = 0; n < 2; ++n) acc[a][b][m][n] = (f32x4){0.f, 0.f, 0.f, 0.f};
        cur = nxt; cA = nA; cB = nB; ++ui;
        if (wr == 1) PG8_BAR;
    }
    PG8_WAIT_V(0);
    PG8_BAR;
    if constexpr (Epi::AFTER_DRAIN) { E.fused(acc, cur, wr, wc, fr, fq, lds, wid, lane); S.done(cur); }
    PG8_STAMP();
    if (STAMP && wid == 0) { stamps[lane] = lane < nts ? (((unsigned long long)(unsigned)ts_hi << 32) | (unsigned)ts_lo) : 0ull;
        if (lane == 62) stamps[62] = rt_entry; if (lane == 63) stamps[63] = (unsigned long long)wall_clock64(); }
#undef PG8_STAMP
#undef PG8_SA
#undef PG8_SB
#undef PG8_STAGE
#undef PG8_LDA
#undef PG8_LDB
#undef PG8_MMA
#undef PG8_WAIT_V
#undef PG8_WAIT_L
#undef PG8_BAR
#undef PG8_SCHED
}
}

using pg8::bf16_t; using pg8::bf16x8; using pg8::f32x4; using pg8::cvt_pk_bf16;
#define LAS __attribute__((address_space(3)))
typedef unsigned u32x2 __attribute__((ext_vector_type(2)));
typedef unsigned u32x4 __attribute__((ext_vector_type(4)));

constexpr int DM = 2048, MT = 8704, NZ = 7168, DFF = 5632, DFF2 = 11264, NCS = 136;
constexpr int LDS_BYTES = 131072 + 16;
#ifndef STOP_AFTER
#define STOP_AFTER 0
#endif
#ifndef REP_P0
#define REP_P0 1
#endif
#ifndef REP_GI
#define REP_GI 1
#endif
#ifndef REP_GU
#define REP_GU 1
#endif
#ifndef REP_PA
#define REP_PA 1
#endif
#ifndef REP_AT
#define REP_AT 1
#endif
#ifndef REP_PC
#define REP_PC 1
#endif
#ifndef REP_XA
#define REP_XA 1
#endif
#ifndef REP_CV
#define REP_CV 1
#endif
#ifndef REP_NB
#define REP_NB 1
#endif

constexpr size_t SZ_WIN = 7168ull * 2048 * 2, SZ_WOUT = 2048ull * 2048 * 2, SZ_WCQ = 512ull * 2048 * 2, SZ_WCKV = 1024ull * 2048 * 2,
                 SZ_WCO = 2048ull * 512 * 2, SZ_WUP = 11264ull * 2048 * 2, SZ_WDN = 2048ull * 5632 * 2, SZ_WG = 8ull * 2048 * 4;
constexpr size_t OFF_WIN = 0, OFF_WOUT = OFF_WIN + SZ_WIN, OFF_WCQ = OFF_WOUT + SZ_WOUT, OFF_WCKV = OFF_WCQ + SZ_WCQ, OFF_WCO = OFF_WCKV + SZ_WCKV,
                 OFF_WUP = OFF_WCO + SZ_WCO, OFF_WDN = OFF_WUP + SZ_WUP, OFF_WG = OFF_WDN + SZ_WDN, SZ_LAYER = OFF_WG + SZ_WG;
constexpr size_t WS_X = 2 * SZ_LAYER;
constexpr size_t WS_H = WS_X + (size_t)MT * DM * 4;
constexpr size_t WS_HMEM = WS_H + (size_t)MT * DM * 2;
constexpr size_t WS_MKV = WS_HMEM + 2ull * 256 * 2048 * 2;
constexpr size_t WS_D = WS_MKV + 2ull * 256 * 1024 * 2;
constexpr size_t WS_Z = WS_D, WS_CD = WS_D + (size_t)MT * NZ * 2, WS_U = WS_D;
constexpr size_t WS_E = WS_D + (size_t)MT * DFF2 * 2;
constexpr size_t WS_MIX = WS_E, WS_QC = WS_E, WS_OC = WS_E + 16ull * 1024 * 1024, WS_ACT = WS_E, WS_QCF = WS_E + 32ull * 1024 * 1024;
constexpr size_t WS_S = WS_E + (size_t)MT * DFF * 2;
constexpr size_t WS_IG = WS_S, WS_LF = WS_IG + (size_t)MT * 4 * 4, WS_BL = WS_LF + (size_t)MT * 4 * 4, WS_GMAX = WS_BL + 4096, WS_MENT = WS_GMAX + 4096,
                 WS_DN = WS_MENT + 4096, WS_NENT = WS_DN + (size_t)NCS * 4 * 256 * 4, WS_BAR = WS_NENT + (size_t)NCS * 4 * 256 * 4, WS_TT = WS_BAR + 16384, WS_END = WS_TT + 4096;
static_assert(WS_CD + (size_t)NCS * 4 * 65536 * 2 <= WS_E, "region D");

constexpr size_t O_YP = 0, O_YS = O_YP + 8192ull * 2048, O_PC = O_YS + 512ull * 2048, O_PN = O_PC + 2ull * 4 * 65536, O_PM = O_PN + 2 * 4 * 256,
                 O_PK = O_PM + 8, O_PV = O_PK + 2ull * 512 * 1024, O_PMK = O_PV + 2ull * 512 * 1024, O_PMV = O_PMK + 2ull * 256 * 512,
                 O_PCONV = O_PMV + 2ull * 256 * 512, O_SC = O_PCONV + 2ull * 2 * DFF2, O_SN = O_SC + 2ull * 8 * 4 * 65536, O_SM = O_SN + 2ull * 8 * 4 * 256,
                 O_SK = O_SM + 64, O_SV = O_SK + 2ull * 8 * 64 * 1024, O_SCONV = O_SV + 2ull * 8 * 64 * 1024, O_END = O_SCONV + 2ull * 8 * 2 * DFF2;

struct Params { const float* in[29]; float* out; unsigned char* ws; };
enum { I_XP = 0, I_XS, I_MEM, I_CAK, I_CAV, I_CMK, I_CMV, I_SC, I_SN, I_SM, I_SCONV, I_GMIX, I_WIN, I_BI, I_BF, I_GHEAD, I_REL, I_WOUT, I_GCROSS, I_GMEM, I_WCQ, I_WCKV,
       I_WCO, I_GFFN, I_WUP, I_CONVW, I_CONVB, I_WDN, I_GFINAL };

__device__ __forceinline__ int otid() { int t = threadIdx.x; asm volatile("" : "+v"(t)); return t; }
__device__ __forceinline__ int obid() { int t = blockIdx.x; asm volatile("" : "+s"(t)); return t; }
__device__ __forceinline__ unsigned short f2bf(float f) { unsigned u = __float_as_uint(f); u += 0x7FFFu + ((u >> 16) & 1u); return (unsigned short)(u >> 16); }
__device__ __forceinline__ float bflo(unsigned w) { return __uint_as_float(w << 16); }
__device__ __forceinline__ float bfhi(unsigned w) { return __uint_as_float(w & 0xffff0000u); }
__device__ __forceinline__ f32x4 mfma16(bf16x8 a, bf16x8 b, f32x4 c) { return __builtin_amdgcn_mfma_f32_16x16x32_bf16(a, b, c, 0, 0, 0); }
__device__ __forceinline__ u32x4 ld8(const void* p, size_t eoff, bool isf) {
    if (isf) { const float* f = (const float*)p + eoff; const f32x4 a = *(const f32x4*)f, b = *(const f32x4*)(f + 4);
        u32x4 w; w.x = cvt_pk_bf16(a[0], a[1]); w.y = cvt_pk_bf16(a[2], a[3]); w.z = cvt_pk_bf16(b[0], b[1]); w.w = cvt_pk_bf16(b[2], b[3]); return w; }
    return *(const u32x4*)((const bf16_t*)p + eoff);
}
__device__ __forceinline__ void st_tr8(LAS unsigned short* T, int ldt, int c8, int r, u32x4 w) {
    T[(c8 + 0) * ldt + r] = (unsigned short)(w.x & 0xffffu); T[(c8 + 1) * ldt + r] = (unsigned short)(w.x >> 16);
    T[(c8 + 2) * ldt + r] = (unsigned short)(w.y & 0xffffu); T[(c8 + 3) * ldt + r] = (unsigned short)(w.y >> 16);
    T[(c8 + 4) * ldt + r] = (unsigned short)(w.z & 0xffffu); T[(c8 + 5) * ldt + r] = (unsigned short)(w.z >> 16);
    T[(c8 + 6) * ldt + r] = (unsigned short)(w.w & 0xffffu); T[(c8 + 7) * ldt + r] = (unsigned short)(w.w >> 16);
}
__device__ __forceinline__ float wsum(float v) { v += __shfl_xor(v, 1); v += __shfl_xor(v, 2); v += __shfl_xor(v, 4); v += __shfl_xor(v, 8); v += __shfl_xor(v, 16); v += __shfl_xor(v, 32); return v; }

__device__ __forceinline__ void convw(LAS unsigned char* L, const float* __restrict__ src, int ld, int K, int N, bf16_t* __restrict__ dst, int skip) {
    LAS unsigned short* T = (LAS unsigned short*)L;
    const int tid = otid(), nkt = K >> 6, ntl = nkt * (N >> 6);
    const int kk = tid >> 4, n4 = (tid & 15) * 4;
    int t = blockIdx.x; if (t >= ntl) return;
    f32x4 v[2];
    { const int kt = t % nkt, nt = t / nkt, k0 = kt * 64, n0 = nt * 64, nsrc = n0 + ((skip && n0 >= 3072) ? 8 : 0);
#pragma unroll
      for (int hf = 0; hf < 2; ++hf) v[hf] = __builtin_nontemporal_load((const f32x4*)(src + (size_t)(k0 + kk + hf * 32) * ld + nsrc + n4)); }
    for (; t < ntl; t += gridDim.x) {
        const int kt = t % nkt, nt = t / nkt, k0 = kt * 64, n0 = nt * 64;
#pragma unroll
        for (int hf = 0; hf < 2; ++hf) { const int k = kk + hf * 32;
            T[(n4 + 0) * 72 + k] = f2bf(v[hf][0]); T[(n4 + 1) * 72 + k] = f2bf(v[hf][1]); T[(n4 + 2) * 72 + k] = f2bf(v[hf][2]); T[(n4 + 3) * 72 + k] = f2bf(v[hf][3]); }
        __syncthreads();
        const int t2 = t + gridDim.x;
        if (t2 < ntl) { const int kt2 = t2 % nkt, nt2 = t2 / nkt, k02 = kt2 * 64, n02 = nt2 * 64, nsrc = n02 + ((skip && n02 >= 3072) ? 8 : 0);
#pragma unroll
            for (int hf = 0; hf < 2; ++hf) v[hf] = __builtin_nontemporal_load((const f32x4*)(src + (size_t)(k02 + kk + hf * 32) * ld + nsrc + n4)); }
        { const int n = tid >> 3, k8 = (tid & 7) * 8; const u32x4 w = *(LAS u32x4*)(T + n * 72 + k8); *(u32x4*)(dst + (size_t)(n0 + n) * K + k0 + k8) = w; }
        __syncthreads();
    }
}

__device__ __forceinline__ void norm_phase(LAS unsigned char* L, const float* xp, const float* xs, float* X, const float* __restrict__ g, bf16_t* H, float* yout, int rows, int mode,
                                           const float* WG, const float* bi, const float* bfg, float* IG, float* LF, const int* TT = nullptr, const float* PART = nullptr, int S = 0, int b0 = 0) {
    const int tid = otid(), lane = tid & 63, wave = tid >> 6;
    if ((int)blockIdx.x < b0) return;
    LAS float* WGs = (LAS float*)L;
    LAS int* tts = (LAS int*)(L + 65536);
    if ((mode & 2) || S > 0) { if (mode & 2) for (int i = tid; i < 8 * 2048; i += 512) WGs[i] = WG[i];
        if (S > 0 && tid < 272) tts[tid] = TT[tid];
        __syncthreads(); }
    const int rstep = ((int)gridDim.x - b0) * 8;
    int row = ((int)blockIdx.x - b0) * 8 + wave;
    f32x4 nx[8];
    if (row < rows) { const float* src = (mode & 1) ? (row < 8192 ? xp + (size_t)row * DM : xs + (size_t)(row - 8192) * DM) : X + (size_t)row * DM;
#pragma unroll
        for (int i = 0; i < 8; ++i) nx[i] = *(const f32x4*)(src + i * 256 + lane * 4); }
    for (; row < rows; row += rstep) {
        f32x4 xv[8]; float ss = 0.f;
#pragma unroll
        for (int i = 0; i < 8; ++i) { xv[i] = nx[i]; ss += xv[i][0] * xv[i][0] + xv[i][1] * xv[i][1] + xv[i][2] * xv[i][2] + xv[i][3] * xv[i][3]; }
        { const int rn = row + rstep; if (rn < rows) { const float* src = (mode & 1) ? (rn < 8192 ? xp + (size_t)rn * DM : xs + (size_t)(rn - 8192) * DM) : X + (size_t)rn * DM;
#pragma unroll
            for (int i = 0; i < 8; ++i) nx[i] = *(const f32x4*)(src + i * 256 + lane * 4); } }
        if (S > 0) { const int pm = row >> 8;
#pragma unroll
            for (int i = 0; i < 8; ++i) { const int sl = __builtin_amdgcn_readfirstlane(tts[pm * 8 + i]);
                if (sl) { const float* pp = PART + (size_t)((sl - 1) * S) * 65536 + (size_t)(row & 255) * 256 + lane * 4;
                    for (int kc = 0; kc < S; ++kc) xv[i] = xv[i] + *(const f32x4*)(pp + (size_t)kc * 65536);
                    *(f32x4*)(X + (size_t)row * DM + i * 256 + lane * 4) = xv[i]; } }
            ss = 0.f;
#pragma unroll
            for (int i = 0; i < 8; ++i) ss += xv[i][0] * xv[i][0] + xv[i][1] * xv[i][1] + xv[i][2] * xv[i][2] + xv[i][3] * xv[i][3]; }
        ss = wsum(ss);
        const float r = rsqrtf(ss * (1.0f / 2048.0f) + 1e-6f);
        if (mode & 1) {
#pragma unroll
            for (int i = 0; i < 8; ++i) *(f32x4*)(X + (size_t)row * DM + i * 256 + lane * 4) = xv[i];
        }
#pragma unroll
        for (int i = 0; i < 8; ++i) { const f32x4 gv = *(const f32x4*)(g + i * 256 + lane * 4); xv[i] = xv[i] * r * gv;
            if (mode & 4) __builtin_nontemporal_store(xv[i], (f32x4*)(yout + (size_t)row * DM + i * 256 + lane * 4));
            else { u32x2 w; w.x = cvt_pk_bf16(xv[i][0], xv[i][1]); w.y = cvt_pk_bf16(xv[i][2], xv[i][3]); *(u32x2*)(H + (size_t)row * DM + i * 256 + lane * 4) = w; } }
        if (mode & 2) {
            float z[8];
#pragma unroll
            for (int j = 0; j < 8; ++j) { float a = 0.f;
#pragma unroll
                for (int i = 0; i < 8; ++i) { const f32x4 wv = *(LAS f32x4*)(WGs + j * 2048 + i * 256 + lane * 4); a += xv[i][0] * wv[0] + xv[i][1] * wv[1] + xv[i][2] * wv[2] + xv[i][3] * wv[3]; }
                z[j] = wsum(a); asm volatile("" ::: "memory"); }
            if (lane == 0) {
#pragma unroll
                for (int j = 0; j < 4; ++j) { IG[row * 4 + j] = z[j] + bi[j]; const float f = z[4 + j] + bfg[j]; LF[row * 4 + j] = fminf(f, 0.f) - log1pf(__expf(-fabsf(f))); } }
        }
    }
    __syncthreads();
}

struct EpiRes {
    static constexpr bool PERM = false, AFTER_DRAIN = false;
    float* X; int atomic; float* part;
    __device__ __forceinline__ void operator()(const f32x4 (&acc)[2][2][4][2], const pg8::Unit& u, int wr, int wc, int fr, int fq) const {
        const int row0 = u.pm * 256 + wr * 64 + fr, col0 = u.pn * 256 + wc * 32 + 4 * fq;
        if (atomic < 0) {
            float* pb = part + (size_t)u.kc * ((size_t)MT * 512) + (size_t)row0 * 512 + col0;
#pragma unroll
            for (int ai = 0; ai < 2; ++ai)
#pragma unroll
                for (int m = 0; m < 4; ++m)
#pragma unroll
                    for (int bj = 0; bj < 2; ++bj)
#pragma unroll
                        for (int n = 0; n < 2; ++n) *(f32x4*)(pb + (size_t)(ai * 128 + m * 16) * 512 + bj * 128 + n * 16) = acc[ai][bj][m][n];
            return; }
        if (atomic) {
            float* pb = part + (size_t)(u.slot * atomic + u.kc) * 65536 + (size_t)(wr * 64 + fr) * 256 + wc * 32 + 4 * fq;
#pragma unroll
            for (int ai = 0; ai < 2; ++ai)
#pragma unroll
                for (int m = 0; m < 4; ++m)
#pragma unroll
                    for (int bj = 0; bj < 2; ++bj)
#pragma unroll
                        for (int n = 0; n < 2; ++n) *(f32x4*)(pb + (size_t)(ai * 128 + m * 16) * 256 + bj * 128 + n * 16) = acc[ai][bj][m][n];
            return; }
#pragma unroll
        for (int ai = 0; ai < 2; ++ai) {
            f32x4 t[4][2][2];
#pragma unroll
            for (int m = 0; m < 4; ++m) { const float* rowp = X + (size_t)(row0 + ai * 128 + m * 16) * DM + col0;
#pragma unroll
                for (int bj = 0; bj < 2; ++bj)
#pragma unroll
                    for (int n = 0; n < 2; ++n) t[m][bj][n] = *(const f32x4*)(rowp + bj * 128 + n * 16); }
#pragma unroll
            for (int m = 0; m < 4; ++m) { float* rowp = X + (size_t)(row0 + ai * 128 + m * 16) * DM + col0;
#pragma unroll
                for (int bj = 0; bj < 2; ++bj)
#pragma unroll
                    for (int n = 0; n < 2; ++n) *(f32x4*)(rowp + bj * 128 + n * 16) = t[m][bj][n] + acc[ai][bj][m][n]; }
            asm volatile("" ::: "memory"); }
    }
};
struct EpiGen {
    static constexpr bool PERM = true, AFTER_DRAIN = false;
    bf16_t* O; int ldc; int mode;
    __device__ __forceinline__ void operator()(const f32x4 (&acc)[2][2][4][2], const pg8::Unit& u, int wr, int wc, int fr, int fq) const {
        const int row0 = u.pm * 256 + wr * 64 + fr, col0 = u.pn * 256 + wc * 32 + 8 * fq; const int blk = mode ? (u.pn >> 2) : 0;
#pragma unroll
        for (int ai = 0; ai < 2; ++ai)
#pragma unroll
            for (int m = 0; m < 4; ++m) { bf16_t* rowp = O + (size_t)(row0 + ai * 128 + m * 16) * ldc + col0;
#pragma unroll
                for (int bj = 0; bj < 2; ++bj) { f32x4 v0 = acc[ai][bj][m][0], v1 = acc[ai][bj][m][1];
                    if (blk == 1) { v0 = v0 * 0.0625f; v1 = v1 * 0.0625f; }
                    else if (blk == 3) {
#pragma unroll
                        for (int j = 0; j < 4; ++j) { v0[j] = __builtin_amdgcn_rcpf(1.0f + __expf(-v0[j])); v1[j] = __builtin_amdgcn_rcpf(1.0f + __expf(-v1[j])); } }
                    u32x4 w; w.x = cvt_pk_bf16(v0[0], v0[1]); w.y = cvt_pk_bf16(v0[2], v0[3]); w.z = cvt_pk_bf16(v1[0], v1[1]); w.w = cvt_pk_bf16(v1[2], v1[3]);
                    *(u32x4*)(rowp + bj * 128) = w; }
                asm volatile("" ::: "memory"); }
    }
};
__device__ __forceinline__ void copy_bf_f32(const bf16_t* src, int lds_, float* dst, int ldd, int rows, int rowg) {
    const int gt = obid() * 512 + otid(), nthr = gridDim.x * 512;
    for (int i = gt; i < rows * rowg; i += nthr) { const int r = i / rowg, c = (i - r * rowg) * 8; const u32x4 w = *(const u32x4*)(src + (size_t)r * lds_ + c);
        float* d = dst + (size_t)r * ldd + c; *(f32x4*)d = (f32x4){bflo(w.x), bfhi(w.x), bflo(w.y), bfhi(w.y)}; *(f32x4*)(d + 4) = (f32x4){bflo(w.z), bfhi(w.z), bflo(w.w), bfhi(w.w)}; }
}
template <class Epi> __device__ __forceinline__ void run_gemm(LAS unsigned char* L, const bf16_t* A, const bf16_t* Bt, int M, int N, int K, const Epi& E, int lim = -1, int split = 0, int cshift = 0) {
    pg8::Gemm g{A, Bt, M, N, split > 0 ? K / split : K, K}; pg8::StaticOrder S; S.init(M, N, (int)gridDim.x, ((int)blockIdx.x + cshift) % (int)gridDim.x); if (lim >= 0) S.lim = lim; S.S = split;
    pg8::gemm_phase<Epi, pg8::StaticOrder, false>(L, g, S, E, nullptr);
    __syncthreads();
}

typedef short s16x4 __attribute__((ext_vector_type(4)));
constexpr int AT_QS = 0, AT_KS = 17408, AT_VS = 52224, AT_BT = 89088, AT_CM = 91200, AT_CO = 91712;
__device__ __forceinline__ void kv_src(int type, int l, int c, int h, int kt, const bf16_t* Z, const bf16_t* MKV, const float* ck, const float* cv, const void*& kp, const void*& vp, int& ld, bool& isf) {
    if (type == 0) { const int cc = c - 8 + kt; kp = Z + (size_t)(cc * 64) * NZ + 5120 + h * 128; vp = (const bf16_t*)kp + 1024; ld = NZ; isf = false; }
    else if (type == 1) { if (kt < 8) { const size_t o_ = ((size_t)((l * 8 + c) * 512 + kt * 64)) * 1024 + h * 128; kp = ck + o_; vp = cv + o_; ld = 1024; isf = true; }
                          else { kp = Z + (size_t)(8192 + c * 64) * NZ + 5120 + h * 128; vp = (const bf16_t*)kp + 1024; ld = NZ; isf = false; } }
    else if (type == 2) { kp = MKV + (size_t)(kt * 64) * 1024 + h * 128; vp = (const bf16_t*)kp + 512; ld = 1024; isf = false; }
    else { const size_t o_ = ((size_t)((l * 8 + c) * 256 + kt * 64)) * 512 + h * 128; kp = ck + o_; vp = cv + o_; ld = 512; isf = true; }
}
struct Raw8 { u32x4 a, b; };
__device__ __forceinline__ Raw8 ldraw(const void* p, size_t eoff, bool isf) { Raw8 r;
    if (isf) { const float* f = (const float*)p + eoff; r.a = *(const u32x4*)f; r.b = *(const u32x4*)(f + 4); } else { r.a = *(const u32x4*)((const bf16_t*)p + eoff); r.b = r.a; } return r; }
__device__ __forceinline__ u32x4 cvraw(const Raw8& r, bool isf) {
    if (!isf) return r.a;
    u32x4 w; w.x = cvt_pk_bf16(__uint_as_float(r.a.x), __uint_as_float(r.a.y)); w.y = cvt_pk_bf16(__uint_as_float(r.a.z), __uint_as_float(r.a.w));
    w.z = cvt_pk_bf16(__uint_as_float(r.b.x), __uint_as_float(r.b.y)); w.w = cvt_pk_bf16(__uint_as_float(r.b.z), __uint_as_float(r.b.w)); return w; }
template <bool BIAS> __device__ __forceinline__ void attn_unit(LAS unsigned char* L, int type, int l, int c  , int h, const bf16_t* Q, int ldq, const bf16_t* Z, const bf16_t* MKV,
                                          const float* ck, const float* cv, const float* bias, bf16_t* O, int ldo, const float* Qf = nullptr) {
    const int tid = otid(), lane = tid & 63, w = tid >> 6, qt = w & 3, kh = w >> 2, fr = lane & 15, fq = lane >> 4;
    const int ntile = (type < 2) ? 9 : 4, tile0 = (type == 0 && c < 8) ? 8 - c : 0;
    LAS float* bt = (LAS float*)(L + AT_BT);
    const int sr0 = tid >> 4, sc8 = (tid & 15) * 8;
    __syncthreads();
#pragma unroll
    for (int i = 0; i < 2; ++i) { const int r = sr0 + i * 32;
        if (Qf) { const float* q0 = Qf + (size_t)r * 512 + sc8; const float* q1 = q0 + (size_t)MT * 512;
            const f32x4 a = *(const f32x4*)q0 + *(const f32x4*)q1, b = *(const f32x4*)(q0 + 4) + *(const f32x4*)(q1 + 4);
            u32x4 wq; wq.x = cvt_pk_bf16(a[0], a[1]); wq.y = cvt_pk_bf16(a[2], a[3]); wq.z = cvt_pk_bf16(b[0], b[1]); wq.w = cvt_pk_bf16(b[2], b[3]); *(LAS u32x4*)(L + AT_QS + (r * 136 + sc8) * 2) = wq; }
        else *(LAS u32x4*)(L + AT_QS + (r * 136 + sc8) * 2) = *(const u32x4*)(Q + (size_t)r * ldq + sc8); }
    if (BIAS) for (int i = tid; i < 513; i += 512) bt[i] = bias[i] * 1.4426950408889634f;
    {
        const void* kp; const void* vp; int ld; bool isf; kv_src(type, l, c, h, tile0, Z, MKV, ck, cv, kp, vp, ld, isf);
#pragma unroll
        for (int i = 0; i < 2; ++i) { const int r = sr0 + i * 32; const Raw8 kr = ldraw(kp, (size_t)r * ld + sc8, isf), vr = ldraw(vp, (size_t)r * ld + sc8, isf);
            *(LAS u32x4*)(L + AT_KS + (r * 136 + sc8) * 2) = cvraw(kr, isf); *(LAS u32x4*)(L + AT_VS + (r * 144 + sc8) * 2) = cvraw(vr, isf); }
    }
    __syncthreads();
    bf16x8 qf[4];
#pragma unroll
    for (int ks = 0; ks < 4; ++ks) qf[ks] = *(LAS bf16x8*)(L + AT_QS + ((qt * 16 + fr) * 136 + ks * 32 + fq * 8) * 2);
    float m_run = -1e30f, l_run = 0.f; f32x4 o[8];
#pragma unroll
    for (int i = 0; i < 8; ++i) o[i] = (f32x4){0.f, 0.f, 0.f, 0.f};
    const float scale = 0.08838834764831845f * 1.4426950408889634f;
    for (int kt = tile0; kt < ntile; ++kt) {
        const int buf = (kt - tile0) & 1; const bool more = (kt + 1 < ntile);
        Raw8 kr[2], vr[2]; bool isf = false;
        if (more) { const void* kp; const void* vp; int ld; kv_src(type, l, c, h, kt + 1, Z, MKV, ck, cv, kp, vp, ld, isf);
#pragma unroll
            for (int i = 0; i < 2; ++i) { const int r = sr0 + i * 32; kr[i] = ldraw(kp, (size_t)r * ld + sc8, isf); vr[i] = ldraw(vp, (size_t)r * ld + sc8, isf); } }
        LAS unsigned char* Kb = L + AT_KS + buf * 17408; LAS unsigned char* Vb = L + AT_VS + buf * 18432;
        f32x4 s[2];
        __builtin_amdgcn_s_setprio(1);
#pragma unroll
        for (int st = 0; st < 2; ++st) { s[st] = (f32x4){0.f, 0.f, 0.f, 0.f};
#pragma unroll
            for (int ks = 0; ks < 4; ++ks) { const bf16x8 kf = *(LAS bf16x8*)(Kb + ((kh * 32 + st * 16 + fr) * 136 + ks * 32 + fq * 8) * 2); s[st] = mfma16(kf, qf[ks], s[st]); } }
        __builtin_amdgcn_s_setprio(0);
        float mx = -1e30f;
#pragma unroll
        for (int st = 0; st < 2; ++st)
#pragma unroll
            for (int j = 0; j < 4; ++j) { float v = s[st][j] * scale;
                if (BIAS) { int rel = 512 + (qt * 16 + fr) - (kt * 64 + kh * 32 + st * 16 + fq * 4 + j); rel = rel > 256 ? 256 : rel; v += bt[rel + 256]; }
                s[st][j] = v; mx = fmaxf(mx, v); }
        mx = fmaxf(mx, __shfl_xor(mx, 16)); mx = fmaxf(mx, __shfl_xor(mx, 32));
        float alpha = 1.0f;
        if (!__all(mx - m_run <= 11.5f)) { const float m_new = fmaxf(m_run, mx); alpha = __builtin_amdgcn_exp2f(m_run - m_new); m_run = m_new;
#pragma unroll
            for (int i = 0; i < 8; ++i) o[i] = o[i] * alpha; }
        float rs = 0.f;
#pragma unroll
        for (int st = 0; st < 2; ++st)
#pragma unroll
            for (int j = 0; j < 4; ++j) { const float pv = __builtin_amdgcn_exp2f(s[st][j] - m_run); s[st][j] = pv; rs += pv; }
        l_run = l_run * alpha + rs;
        u32x4 pw; pw.x = cvt_pk_bf16(s[0][0], s[0][1]); pw.y = cvt_pk_bf16(s[0][2], s[0][3]); pw.z = cvt_pk_bf16(s[1][0], s[1][1]); pw.w = cvt_pk_bf16(s[1][2], s[1][3]);
        const bf16x8 pf = __builtin_bit_cast(bf16x8, pw);
        LAS unsigned char* vrow = Vb + ((kh * 32 + 4 * fq + (fr >> 2)) * 144 + (fr & 3) * 4) * 2;
        __builtin_amdgcn_s_setprio(1);
#pragma unroll
        for (int i = 0; i < 8; ++i) { const s16x4 v0 = __builtin_amdgcn_ds_read_tr16_b64_v4i16((LAS s16x4*)(vrow + i * 32)), v1 = __builtin_amdgcn_ds_read_tr16_b64_v4i16((LAS s16x4*)(vrow + 16 * 288 + i * 32));
            const bf16x8 vf = {v0[0], v0[1], v0[2], v0[3], v1[0], v1[1], v1[2], v1[3]}; o[i] = mfma16(vf, pf, o[i]); }
        __builtin_amdgcn_s_setprio(0);
        if (more) { LAS unsigned char* Kn = L + AT_KS + (buf ^ 1) * 17408; LAS unsigned char* Vn = L + AT_VS + (buf ^ 1) * 18432;
#pragma unroll
            for (int i = 0; i < 2; ++i) { const int r = sr0 + i * 32; *(LAS u32x4*)(Kn + (r * 136 + sc8) * 2) = cvraw(kr[i], isf); *(LAS u32x4*)(Vn + (r * 144 + sc8) * 2) = cvraw(vr[i], isf); } }
        __syncthreads();
    }
    l_run += __shfl_xor(l_run, 16); l_run += __shfl_xor(l_run, 32);
    LAS float* cm = (LAS float*)(L + AT_CM); LAS float* co = (LAS float*)(L + AT_CO);
    if (kh == 1) { if (fq == 0) { cm[qt * 16 + fr] = m_run; cm[64 + qt * 16 + fr] = l_run; }
#pragma unroll
        for (int i = 0; i < 8; ++i)
#pragma unroll
            for (int j = 0; j < 4; ++j) co[(qt * 128 + i * 16 + fq * 4 + j) * 16 + fr] = o[i][j]; }
    __syncthreads();
    if (kh == 0) { const float m1 = cm[qt * 16 + fr], l1 = cm[64 + qt * 16 + fr]; const float m = fmaxf(m_run, m1), a0 = __builtin_amdgcn_exp2f(m_run - m), a1 = __builtin_amdgcn_exp2f(m1 - m);
        const float inv = 1.0f / (l_run * a0 + l1 * a1);
#pragma unroll
        for (int i = 0; i < 8; ++i) { float r[4];
#pragma unroll
            for (int j = 0; j < 4; ++j) r[j] = (o[i][j] * a0 + co[(qt * 128 + i * 16 + fq * 4 + j) * 16 + fr] * a1) * inv;
            u32x2 pk; pk.x = cvt_pk_bf16(r[0], r[1]); pk.y = cvt_pk_bf16(r[2], r[3]); *(u32x2*)(O + (size_t)(qt * 16 + fr) * ldo + i * 16 + fq * 4) = pk; } }
}

constexpr int PA_VT = 0, PA_KT = 34816, PA_ES = 69632;
__device__ __forceinline__ void mlstm_pa(LAS unsigned char* L, int cs, int h, const bf16_t* Z, const float* IG, const float* LF, bf16_t* CD, float* DN, float* BL, float* GMAX) {
    const int tid = otid(), lane = tid & 63, w = tid >> 6, fr = lane & 15, fq = lane >> 4, row0 = cs * 64;
    LAS float* es = (LAS float*)(L + PA_ES);
    __syncthreads();
    if (w == 0) { float b = LF[(row0 + lane) * 4 + h]; const float ig = IG[(row0 + lane) * 4 + h];
#pragma unroll
        for (int off = 1; off < 64; off <<= 1) { const float v = __shfl_up(b, off); if (lane >= off) b += v; }
        const float bL = __shfl(b, 63); const float xg = ig - b; float mx = xg;
#pragma unroll
        for (int off = 1; off < 64; off <<= 1) mx = fmaxf(mx, __shfl_xor(mx, off));
        es[lane] = __expf(xg - mx);
        if (lane == 0) { BL[cs * 4 + h] = bL; GMAX[cs * 4 + h] = bL + mx; } }
    __syncthreads();
#pragma unroll
    for (int i = 0; i < 4; ++i) { const int idx = tid + i * 512, s = idx >> 5, c8 = (idx & 31) * 8; const float e = es[s];
        const u32x4 kw = *(const u32x4*)(Z + (size_t)(row0 + s) * NZ + 1024 + h * 256 + c8); *(LAS u32x4*)(L + PA_KT + (s * 272 + c8) * 2) = kw;
        u32x4 vw = *(const u32x4*)(Z + (size_t)(row0 + s) * NZ + 2048 + h * 256 + c8);
        vw.x = cvt_pk_bf16(bflo(vw.x) * e, bfhi(vw.x) * e); vw.y = cvt_pk_bf16(bflo(vw.y) * e, bfhi(vw.y) * e); vw.z = cvt_pk_bf16(bflo(vw.z) * e, bfhi(vw.z) * e); vw.w = cvt_pk_bf16(bflo(vw.w) * e, bfhi(vw.w) * e);
        *(LAS u32x4*)(L + PA_VT + (s * 272 + c8) * 2) = vw; }
    __syncthreads();
    bf16_t* Cd = CD + (size_t)(cs * 4 + h) * 65536;
    const int troff = ((4 * fq + (fr >> 2)) * 272 + (fr & 3) * 4) * 2;
#pragma unroll 1
    for (int vt = 0; vt < 2; ++vt) { const int vb = w * 32 + vt * 16;
        bf16x8 vf[2];
#pragma unroll
        for (int ks = 0; ks < 2; ++ks) { LAS unsigned char* a_ = L + PA_VT + troff + ks * 32 * 544 + vb * 2;
            const s16x4 v0 = __builtin_amdgcn_ds_read_tr16_b64_v4i16((LAS s16x4*)a_), v1 = __builtin_amdgcn_ds_read_tr16_b64_v4i16((LAS s16x4*)(a_ + 16 * 544));
            vf[ks] = (bf16x8){v0[0], v0[1], v0[2], v0[3], v1[0], v1[1], v1[2], v1[3]}; }
#pragma unroll 4
        for (int k2 = 0; k2 < 16; ++k2) { f32x4 a = (f32x4){0.f, 0.f, 0.f, 0.f};
#pragma unroll
            for (int ks = 0; ks < 2; ++ks) { LAS unsigned char* a_ = L + PA_KT + troff + ks * 32 * 544 + k2 * 32;
                const s16x4 k0 = __builtin_amdgcn_ds_read_tr16_b64_v4i16((LAS s16x4*)a_), k1 = __builtin_amdgcn_ds_read_tr16_b64_v4i16((LAS s16x4*)(a_ + 16 * 544));
                const bf16x8 kf = {k0[0], k0[1], k0[2], k0[3], k1[0], k1[1], k1[2], k1[3]}; a = mfma16(kf, vf[ks], a); }
            u32x2 pk; pk.x = cvt_pk_bf16(a[0], a[1]); pk.y = cvt_pk_bf16(a[2], a[3]); *(u32x2*)(Cd + (size_t)(vb + fr) * 256 + k2 * 16 + fq * 4) = pk; } }
    if (tid < 256) { float a = 0.f; LAS unsigned short* kS = (LAS unsigned short*)(L + PA_KT);
        for (int s = 0; s < 64; ++s) a += es[s] * __uint_as_float(((unsigned)kS[s * 272 + tid]) << 16);
        DN[(size_t)(cs * 4 + h) * 256 + tid] = a; }
}

__device__ __forceinline__ void mlstm_scan(LAS unsigned char* L, int l, const float* __restrict__ BL, const float* __restrict__ GMAX, float* __restrict__ MENT, bf16_t* CD, const float* __restrict__ DN, float* __restrict__ NENT,
                                           const float* __restrict__ sC, const float* __restrict__ sN, const float* __restrict__ sM, float* __restrict__ out) {
    const int tid = otid(); LAS float* As = (LAS float*)L; LAS float* Es = As + NCS * 4; LAS float* Bs = Es + NCS * 4; LAS float* Gs = Bs + NCS * 4; LAS float* Ms = Gs + NCS * 4;
    __syncthreads();
    for (int i = tid; i < NCS * 4; i += 512) { Bs[i] = BL[i]; Gs[i] = GMAX[i]; }
    __syncthreads();
    if (tid < 4) { const int h = tid; float m = 0.f;
        for (int c = 0; c < 128; ++c) { const float bL = Bs[c * 4 + h], gm = Gs[c * 4 + h], mn = fmaxf(bL + m, gm); As[c * 4 + h] = __expf(bL + m - mn); Es[c * 4 + h] = __expf(gm - mn); Ms[c * 4 + h] = m; m = mn; }
        if (blockIdx.x == 0) out[O_PM + l * 4 + h] = m; }
    else if (tid < 36) { const int b = (tid - 4) >> 2, h = (tid - 4) & 3, cs = 128 + b; const float m = sM[(l * 8 + b) * 4 + h];
        const float bL = Bs[cs * 4 + h], gm = Gs[cs * 4 + h], mn = fmaxf(bL + m, gm); As[cs * 4 + h] = __expf(bL + m - mn); Es[cs * 4 + h] = __expf(gm - mn); Ms[cs * 4 + h] = m;
        if (blockIdx.x == 0) out[O_SM + (l * 8 + b) * 4 + h] = mn; }
    __syncthreads();
    if (blockIdx.x == 0) for (int i = tid; i < NCS * 4; i += 512) MENT[i] = Ms[i];
    const int gt = obid() * 512 + tid, nthr = gridDim.x * 512;
    for (int p = gt; p < 131072; p += nthr) { const int h = p >> 15, e2 = (p & 32767) * 2;
        float c0 = 0.f, c1 = 0.f; unsigned* base = (unsigned*)(CD + (size_t)h * 65536 + e2);
        const float2 ci0 = *(const float2*)(sC + (size_t)((l * 8 + 0) * 4 + h) * 65536 + e2);
        unsigned dsm[8]; float2 cis[8];
#pragma unroll
        for (int b = 0; b < 8; ++b) { dsm[b] = base[(size_t)(128 + b) * (4 * 65536 / 2)]; cis[b] = *(const float2*)(sC + (size_t)((l * 8 + b) * 4 + h) * 65536 + e2); }
        (void)ci0;
        for (int c = 0; c < 128; c += 16) { unsigned d[16];
#pragma unroll
            for (int i = 0; i < 16; ++i) d[i] = base[(size_t)(c + i) * (4 * 65536 / 2)];
#pragma unroll
            for (int i = 0; i < 16; ++i) { base[(size_t)(c + i) * (4 * 65536 / 2)] = cvt_pk_bf16(c0, c1); const float a = As[(c + i) * 4 + h], e = Es[(c + i) * 4 + h]; c0 = a * c0 + e * bflo(d[i]); c1 = a * c1 + e * bfhi(d[i]); } }
        *(float2*)(out + O_PC + (size_t)(l * 4 + h) * 65536 + e2) = make_float2(c0, c1);
#pragma unroll
        for (int b = 0; b < 8; ++b) { const int cs = 128 + b; base[(size_t)cs * (4 * 65536 / 2)] = cvt_pk_bf16(cis[b].x, cis[b].y); const float a = As[cs * 4 + h], e = Es[cs * 4 + h];
            *(float2*)(out + O_SC + (size_t)((l * 8 + b) * 4 + h) * 65536 + e2) = make_float2(a * cis[b].x + e * bflo(dsm[b]), a * cis[b].y + e * bfhi(dsm[b])); } }
    for (int e = obid() * 4 + (tid >> 7); e < 1024; e += gridDim.x * 4) {
      if ((tid & 127) == 0) { const int h = e >> 8, k = e & 255; float n = 0.f;
        for (int c = 0; c < 128; c += 16) { float d[16];
#pragma unroll
            for (int i = 0; i < 16; ++i) d[i] = DN[(size_t)((c + i) * 4 + h) * 256 + k];
#pragma unroll
            for (int i = 0; i < 16; ++i) { NENT[(size_t)((c + i) * 4 + h) * 256 + k] = n; n = As[(c + i) * 4 + h] * n + Es[(c + i) * 4 + h] * d[i]; } }
        out[O_PN + (l * 4 + h) * 256 + k] = n;
#pragma unroll
        for (int b = 0; b < 8; ++b) { const int cs = 128 + b; const float ni = sN[((l * 8 + b) * 4 + h) * 256 + k]; const float d = DN[(size_t)(cs * 4 + h) * 256 + k]; NENT[(size_t)(cs * 4 + h) * 256 + k] = ni;
            out[O_SN + ((l * 8 + b) * 4 + h) * 256 + k] = As[cs * 4 + h] * ni + Es[cs * 4 + h] * d; } } }
}

constexpr int PC_QS = 0, PC_KS = 33792, PC_VT = 67584, PC_PS = 102400, PC_SC = 111616;
__device__ __forceinline__ void mlstm_pc(LAS unsigned char* L, int cs, int h, const bf16_t* Z, const float* IG, const float* LF, const bf16_t* CD, const float* NENT, const float* MENT,
                                         const float* ghead  , bf16_t* MIX) {
    const int tid = otid(), lane = tid & 63, w = tid >> 6, fr = lane & 15, fq = lane >> 4, row0 = cs * 64;
    LAS float* sc = (LAS float*)(L + PC_SC);
    LAS float* bcum = sc, *xgs = sc + 64, *mts = sc + 128, *wis = sc + 192, *dns = sc + 256, *psum = sc + 320, *hsq = sc + 576;
    __syncthreads();
    if (w == 0) { float b = LF[(row0 + lane) * 4 + h]; const float ig = IG[(row0 + lane) * 4 + h]; const float m = MENT[cs * 4 + h];
#pragma unroll
        for (int off = 1; off < 64; off <<= 1) { const float v = __shfl_up(b, off); if (lane >= off) b += v; }
        const float xg = ig - b; float pm = xg;
#pragma unroll
        for (int off = 1; off < 64; off <<= 1) { const float v = __shfl_up(pm, off); if (lane >= off) pm = fmaxf(pm, v); }
        const float Mx = fmaxf(m, pm); bcum[lane] = b; xgs[lane] = xg; mts[lane] = b + Mx; wis[lane] = __expf(m - Mx); }
    if (tid >= 256) sc[1088 + (tid - 256)] = NENT[(size_t)(cs * 4 + h) * 256 + (tid - 256)];
#pragma unroll
    for (int i = 0; i < 4; ++i) { const int idx = tid + i * 512, s = idx >> 5, c8 = (idx & 31) * 8; const bf16_t* zr = Z + (size_t)(row0 + s) * NZ + h * 256 + c8;
        *(LAS u32x4*)(L + PC_QS + (s * 264 + c8) * 2) = *(const u32x4*)(zr);
        *(LAS u32x4*)(L + PC_KS + (s * 264 + c8) * 2) = *(const u32x4*)(zr + 1024);
        *(LAS u32x4*)(L + PC_VT + (s * 272 + c8) * 2) = *(const u32x4*)(zr + 2048); }
    __syncthreads();
    {
        const int st = w >> 1, tt0 = (w & 1) * 2; f32x4 sa[2] = {(f32x4){0.f, 0.f, 0.f, 0.f}, (f32x4){0.f, 0.f, 0.f, 0.f}};
#pragma unroll
        for (int ks = 0; ks < 8; ++ks) { const bf16x8 kf = *(LAS bf16x8*)(L + PC_KS + ((st * 16 + fr) * 264 + ks * 32 + fq * 8) * 2);
#pragma unroll
            for (int i = 0; i < 2; ++i) { const bf16x8 qf = *(LAS bf16x8*)(L + PC_QS + (((tt0 + i) * 16 + fr) * 264 + ks * 32 + fq * 8) * 2); sa[i] = mfma16(kf, qf, sa[i]); } }
#pragma unroll
        for (int i = 0; i < 2; ++i) { const int t = (tt0 + i) * 16 + fr; const float ut = bcum[t] - mts[t]; float pr[4]; float rp = 0.f;
#pragma unroll
            for (int j = 0; j < 4; ++j) { const int s = st * 16 + fq * 4 + j; const float v = (s <= t) ? __expf(ut + xgs[s]) * sa[i][j] : 0.f; pr[j] = v; rp += v; }
            u32x2 pk; pk.x = cvt_pk_bf16(pr[0], pr[1]); pk.y = cvt_pk_bf16(pr[2], pr[3]); *(LAS u32x2*)(L + PC_PS + (t * 72 + st * 16 + fq * 4) * 2) = pk;
            rp += __shfl_xor(rp, 16); rp += __shfl_xor(rp, 32); if (fq == 0) psum[st * 64 + t] = rp; }
        const int t = tid >> 3, part = tid & 7; LAS float* nv = sc + 1088 + part * 32; float a = 0.f;
        LAS unsigned char* qrow = L + PC_QS + (t * 264 + part * 32) * 2;
#pragma unroll
        for (int d8 = 0; d8 < 4; ++d8) { const u32x4 qw = *(LAS u32x4*)(qrow + d8 * 16); const f32x4 n0 = *(LAS f32x4*)(nv + d8 * 8), n1 = *(LAS f32x4*)(nv + d8 * 8 + 4);
            a += n0[0] * bflo(qw.x) + n0[1] * bfhi(qw.x) + n0[2] * bflo(qw.y) + n0[3] * bfhi(qw.y) + n1[0] * bflo(qw.z) + n1[1] * bfhi(qw.z) + n1[2] * bflo(qw.w) + n1[3] * bfhi(qw.w); }
        a += __shfl_xor(a, 1); a += __shfl_xor(a, 2); a += __shfl_xor(a, 4); if (part == 0) dns[t] = a;
    }
    __syncthreads();
    const int v0 = w * 32; const bf16_t* Cg = CD + (size_t)(cs * 4 + h) * 65536;
    f32x4 acc[2][4];
#pragma unroll
    for (int vt = 0; vt < 2; ++vt)
#pragma unroll
        for (int tt = 0; tt < 4; ++tt) acc[vt][tt] = (f32x4){0.f, 0.f, 0.f, 0.f};
#pragma unroll
    for (int ks = 0; ks < 8; ++ks) { bf16x8 cf[2];
#pragma unroll
        for (int vt = 0; vt < 2; ++vt) cf[vt] = *(const bf16x8*)(Cg + (size_t)(v0 + vt * 16 + fr) * 256 + ks * 32 + fq * 8);
#pragma unroll
        for (int tt = 0; tt < 4; ++tt) { const bf16x8 qf = *(LAS bf16x8*)(L + PC_QS + ((tt * 16 + fr) * 264 + ks * 32 + fq * 8) * 2);
#pragma unroll
            for (int vt = 0; vt < 2; ++vt) acc[vt][tt] = mfma16(cf[vt], qf, acc[vt][tt]); } }
    float dd[4];
#pragma unroll
    for (int tt = 0; tt < 4; ++tt) { const int t = tt * 16 + fr; const float wi = wis[t];
        const float den = wi * dns[t] + ((psum[t] + psum[64 + t]) + (psum[128 + t] + psum[192 + t])); dd[tt] = 1.0f / fmaxf(fabsf(den), __expf(-mts[t]));
#pragma unroll
        for (int vt = 0; vt < 2; ++vt) acc[vt][tt] = acc[vt][tt] * wi; }
#pragma unroll
    for (int ks = 0; ks < 2; ++ks) { bf16x8 vf[2];
#pragma unroll
        for (int vt = 0; vt < 2; ++vt) { LAS unsigned char* a_ = L + PC_VT + ((ks * 32 + 4 * fq + (fr >> 2)) * 272 + (fr & 3) * 4 + v0 + vt * 16) * 2;
            const s16x4 x0 = __builtin_amdgcn_ds_read_tr16_b64_v4i16((LAS s16x4*)a_), x1 = __builtin_amdgcn_ds_read_tr16_b64_v4i16((LAS s16x4*)(a_ + 16 * 544));
            vf[vt] = (bf16x8){x0[0], x0[1], x0[2], x0[3], x1[0], x1[1], x1[2], x1[3]}; }
#pragma unroll
        for (int tt = 0; tt < 4; ++tt) { LAS unsigned char* b_ = L + PC_PS + ((tt * 16 + fr) * 72 + ks * 32 + fq * 4) * 2;
            const u32x2 p0 = *(LAS u32x2*)b_, p1 = *(LAS u32x2*)(b_ + 32); const u32x4 pw = {p0.x, p0.y, p1.x, p1.y}; const bf16x8 pf = __builtin_bit_cast(bf16x8, pw);
#pragma unroll
            for (int vt = 0; vt < 2; ++vt) acc[vt][tt] = mfma16(vf[vt], pf, acc[vt][tt]); } }
#pragma unroll
    for (int tt = 0; tt < 4; ++tt) { float q = 0.f;
#pragma unroll
        for (int vt = 0; vt < 2; ++vt) { acc[vt][tt] = acc[vt][tt] * dd[tt]; q += acc[vt][tt][0] * acc[vt][tt][0] + acc[vt][tt][1] * acc[vt][tt][1] + acc[vt][tt][2] * acc[vt][tt][2] + acc[vt][tt][3] * acc[vt][tt][3]; }
        q += __shfl_xor(q, 16); q += __shfl_xor(q, 32); if (fq == 0) hsq[w * 64 + tt * 16 + fr] = q; }
    __syncthreads();
#pragma unroll
    for (int tt = 0; tt < 4; ++tt) { const int t = tt * 16 + fr; float tot = 0.f;
#pragma unroll
        for (int ww = 0; ww < 8; ++ww) tot += hsq[ww * 64 + t];
        const float rn = rsqrtf(tot * (1.0f / 256.0f) + 1e-6f); const size_t row = (size_t)(row0 + t);
#pragma unroll
        for (int vt = 0; vt < 2; ++vt) { const int v = v0 + vt * 16 + fq * 4; const u32x2 ow = *(const u32x2*)(Z + row * NZ + 3072 + h * 256 + v); const f32x4 gh = *(const f32x4*)(ghead + h * 256 + v);
            const f32x4 hv = acc[vt][tt] * rn * gh; u32x2 pk; pk.x = cvt_pk_bf16(bflo(ow.x) * hv[0], bfhi(ow.x) * hv[1]); pk.y = cvt_pk_bf16(bflo(ow.y) * hv[2], bfhi(ow.y) * hv[3]);
            *(u32x2*)(MIX + row * DM + h * 256 + v) = pk; } }
}

__device__ __forceinline__ void conv_phase(int l, const bf16_t* __restrict__ U, const float* __restrict__ cw  , const float* __restrict__ cb, const float* __restrict__ sconv  , bf16_t* __restrict__ ACT) {
    const int gt = obid() * 512 + otid(), nthr = gridDim.x * 512;
    for (int task_ = gt; task_ < 272 * 704; task_ += nthr) { const int task = 272 * 704 - 1 - task_;
        const int rr = task / 704, cgi = task - rr * 704, j0 = cgi * 8, r0 = rr * 32;
        float pa2[8], pa1[8], pb2[8], pb1[8];
        const bool seq_start = (r0 < 8192) ? (r0 == 0) : (((r0 - 8192) & 63) == 0);
        if (seq_start) {
            if (r0 == 0) {
#pragma unroll
                for (int i = 0; i < 8; ++i) { pa2[i] = 0.f; pa1[i] = 0.f; pb2[i] = 0.f; pb1[i] = 0.f; } }
            else { const int b = (r0 - 8192) >> 6; const float* s0 = sconv + (size_t)(b * 2) * DFF2; const float* s1 = s0 + DFF2;
#pragma unroll
                for (int i = 0; i < 8; ++i) { pa2[i] = s0[j0 + i]; pa1[i] = s1[j0 + i]; pb2[i] = s0[DFF + j0 + i]; pb1[i] = s1[DFF + j0 + i]; } } }
        else { const u32x4 a2 = *(const u32x4*)(U + (size_t)(r0 - 2) * DFF2 + j0), a1 = *(const u32x4*)(U + (size_t)(r0 - 1) * DFF2 + j0),
                           b2 = *(const u32x4*)(U + (size_t)(r0 - 2) * DFF2 + DFF + j0), b1 = *(const u32x4*)(U + (size_t)(r0 - 1) * DFF2 + DFF + j0);
            pa2[0] = bflo(a2.x); pa2[1] = bfhi(a2.x); pa2[2] = bflo(a2.y); pa2[3] = bfhi(a2.y); pa2[4] = bflo(a2.z); pa2[5] = bfhi(a2.z); pa2[6] = bflo(a2.w); pa2[7] = bfhi(a2.w);
            pa1[0] = bflo(a1.x); pa1[1] = bfhi(a1.x); pa1[2] = bflo(a1.y); pa1[3] = bfhi(a1.y); pa1[4] = bflo(a1.z); pa1[5] = bfhi(a1.z); pa1[6] = bflo(a1.w); pa1[7] = bfhi(a1.w);
            pb2[0] = bflo(b2.x); pb2[1] = bfhi(b2.x); pb2[2] = bflo(b2.y); pb2[3] = bfhi(b2.y); pb2[4] = bflo(b2.z); pb2[5] = bfhi(b2.z); pb2[6] = bflo(b2.w); pb2[7] = bfhi(b2.w);
            pb1[0] = bflo(b1.x); pb1[1] = bfhi(b1.x); pb1[2] = bflo(b1.y); pb1[3] = bfhi(b1.y); pb1[4] = bflo(b1.z); pb1[5] = bfhi(b1.z); pb1[6] = bflo(b1.w); pb1[7] = bfhi(b1.w); }
        float wa0[8], wa1[8], wa2[8], ba[8], wb0[8], wb1[8], wb2[8], bb[8];
#pragma unroll
        for (int i = 0; i < 8; ++i) { wa0[i] = cw[j0 + i]; wa1[i] = cw[DFF2 + j0 + i]; wa2[i] = cw[2 * DFF2 + j0 + i]; ba[i] = cb[j0 + i];
            wb0[i] = cw[DFF + j0 + i]; wb1[i] = cw[DFF2 + DFF + j0 + i]; wb2[i] = cw[2 * DFF2 + DFF + j0 + i]; bb[i] = cb[DFF + j0 + i]; }
#pragma unroll 4
        for (int r = 0; r < 32; ++r) { const size_t row = (size_t)(r0 + r);
            const u32x4 ua = *(const u32x4*)(U + row * DFF2 + j0), ub = *(const u32x4*)(U + row * DFF2 + DFF + j0);
            float ca[8], cbv[8];
            ca[0] = bflo(ua.x); ca[1] = bfhi(ua.x); ca[2] = bflo(ua.y); ca[3] = bfhi(ua.y); ca[4] = bflo(ua.z); ca[5] = bfhi(ua.z); ca[6] = bflo(ua.w); ca[7] = bfhi(ua.w);
            cbv[0] = bflo(ub.x); cbv[1] = bfhi(ub.x); cbv[2] = bflo(ub.y); cbv[3] = bfhi(ub.y); cbv[4] = bflo(ub.z); cbv[5] = bfhi(ub.z); cbv[6] = bflo(ub.w); cbv[7] = bfhi(ub.w);
            float res[8];
#pragma unroll
            for (int i = 0; i < 8; ++i) { const float a = ba[i] + wa0[i] * pa2[i] + wa1[i] * pa1[i] + wa2[i] * ca[i]; const float b = bb[i] + wb0[i] * pb2[i] + wb1[i] * pb1[i] + wb2[i] * cbv[i];
                res[i] = a * __builtin_amdgcn_rcpf(1.0f + __expf(-a)) * b; pa2[i] = pa1[i]; pa1[i] = ca[i]; pb2[i] = pb1[i]; pb1[i] = cbv[i]; }
            u32x4 o; o.x = cvt_pk_bf16(res[0], res[1]); o.y = cvt_pk_bf16(res[2], res[3]); o.z = cvt_pk_bf16(res[4], res[5]); o.w = cvt_pk_bf16(res[6], res[7]);
            *(u32x4*)(ACT + row * DFF + j0) = o; } }
}


#define XB_TMO      128
#define XB_XCNT(j)  (256  + 64 * (j))
#define XB_XSUB(j)  (1280 + 64 * (j))
#define XB_XGEN(j)  (2304 + 64 * (j))
#define XB_TOP      3328
#define XB_TOPGEN   3392
#define XCD_BAR_WORDS 3456
#define XB_SPIN_CAP (1u << 18)

__device__ __forceinline__ unsigned xb_ld(unsigned* p)              { return __hip_atomic_load(p, __ATOMIC_RELAXED, __HIP_MEMORY_SCOPE_AGENT); }
__device__ __forceinline__ unsigned xb_add(unsigned* p, unsigned v) { return __hip_atomic_fetch_add(p, v, __ATOMIC_RELAXED, __HIP_MEMORY_SCOPE_AGENT); }
__device__ __forceinline__ unsigned xb_xcc_id() { return (unsigned)__builtin_amdgcn_s_getreg((3 << 11) | 20) & 0xFu; }
#define XB_SPIN(cond, bar) do { unsigned _sp = 0; while (cond) { __builtin_amdgcn_s_sleep(1); \
    if ((++_sp & 255u) == 0u) { if (xb_ld(&(bar)[XB_TMO])) break; if (_sp > XB_SPIN_CAP) { atomicAdd(&(bar)[XB_TMO], 1u); break; } } } } while (0)

struct XcdBarrier {
    unsigned* bar; unsigned x;
    volatile LAS unsigned* st;
};

__device__ __forceinline__ XcdBarrier xcd_barrier_post(unsigned* bar, volatile LAS unsigned* st) {
    XcdBarrier b; b.bar = bar; b.x = xb_xcc_id(); b.st = st;
    if (threadIdx.x == 0) (void)xb_add(&bar[XB_XCNT(b.x)], 1u);
    return b;
}
__device__ __forceinline__ void xcd_barrier_complete(unsigned* bar, unsigned x, unsigned& nloc, unsigned& nx) {
    const unsigned G = gridDim.x * gridDim.y * gridDim.z;
    unsigned sum, cnt, mine, sp = 0u;
    for (;;) {
        sum = 0u; cnt = 0u; mine = 0u;
#pragma unroll
        for (unsigned j = 0; j < 16; ++j) { const unsigned c = xb_ld(&bar[XB_XCNT(j)]); sum += c; cnt += (c > 0u) ? 1u : 0u; mine = (j == x) ? c : mine; }
        if (sum == G) break;
        __builtin_amdgcn_s_sleep(1);
        if ((++sp & 255u) == 0u) { if (xb_ld(&bar[XB_TMO])) break; if (sp > XB_SPIN_CAP) { atomicAdd(&bar[XB_TMO], 1u); break; } }
    }
    nloc = mine > 0u ? mine : 1u; nx = cnt > 0u ? cnt : 1u;
}

__device__ __forceinline__ void xcd_barrier(const XcdBarrier& b) {
    asm volatile("s_waitcnt vmcnt(0)" ::: "memory");
    __syncthreads();
    if (threadIdx.x == 0) {
        unsigned* bar = b.bar;
        __builtin_amdgcn_s_waitcnt(0);
        unsigned nloc = b.st[0], nx = b.st[1];
        if (nloc == 0u) { xcd_barrier_complete(bar, b.x, nloc, nx); b.st[0] = nloc; b.st[1] = nx; }
        const unsigned old = xb_add(&bar[XB_XSUB(b.x)], 1u);
        const unsigned gen = old / nloc;
        if (old + 1u == (gen + 1u) * nloc) {
            __builtin_amdgcn_fence(__ATOMIC_RELEASE, "agent");
            asm volatile("s_waitcnt vmcnt(0)" ::: "memory");
            const unsigned og = xb_add(&bar[XB_TOP], 1u);
            const unsigned tg = og / nx;
            if (og + 1u == (tg + 1u) * nx) xb_add(&bar[XB_TOPGEN], 1u);
            else XB_SPIN(xb_ld(&bar[XB_TOPGEN]) == tg, bar);
            __builtin_amdgcn_fence(__ATOMIC_ACQUIRE, "agent");
            xb_add(&bar[XB_XGEN(b.x)], 1u);
            asm volatile("s_waitcnt vmcnt(0)" ::: "memory");
        } else {
            XB_SPIN(xb_ld(&bar[XB_XGEN(b.x)]) == gen, bar);
            __builtin_amdgcn_fence(__ATOMIC_ACQUIRE, "agent");
            asm volatile("s_waitcnt vmcnt(0)" ::: "memory");
        }
    }
    __syncthreads();
}


typedef __attribute__((address_space(1))) float* gfptr_t;
typedef const gfptr_t __attribute__((address_space(4)))* ktab_t;
__device__ __forceinline__ const float* ldarg(int i) { ktab_t t = (ktab_t)__builtin_amdgcn_kernarg_segment_ptr(); asm volatile("" : "+s"(t)); const gfptr_t g = t[i]; return (const float*)g; }
#define WSB ((unsigned char*)ldarg(30))
#define OUTB ((float*)ldarg(29))
#define gX_ ((float*)(WSB + WS_X))
#define gH_ ((bf16_t*)(WSB + WS_H))
#define gZ_ ((bf16_t*)(WSB + WS_Z))
#define gCD_ ((bf16_t*)(WSB + WS_CD))
#define gU_ ((bf16_t*)(WSB + WS_U))
#define gMIX_ ((bf16_t*)(WSB + WS_MIX))
#define gQC_ ((bf16_t*)(WSB + WS_QC))
#define gOC_ ((bf16_t*)(WSB + WS_OC))
#define gACT_ ((bf16_t*)(WSB + WS_ACT))
#define gIG_ ((float*)(WSB + WS_IG))
#define gLF_ ((float*)(WSB + WS_LF))
#define gBL_ ((float*)(WSB + WS_BL))
#define gGMAX_ ((float*)(WSB + WS_GMAX))
#define gMENT_ ((float*)(WSB + WS_MENT))
#define gDN_ ((float*)(WSB + WS_DN))
#define gNENT_ ((float*)(WSB + WS_NENT))
#define gPART_ ((float*)(WSB + WS_D))
#define gTT_ ((int*)(WSB + WS_TT))
__global__ void __launch_bounds__(512, 2) mega(Params p) {
    extern __shared__ __attribute__((aligned(16))) unsigned char lds_raw[];
    LAS unsigned char* L = (LAS unsigned char*)lds_raw;
    cg::grid_group grid = cg::this_grid();
    volatile LAS unsigned* xst = (volatile LAS unsigned*)(L + 131072);
    if (threadIdx.x < 4) xst[threadIdx.x] = 0u;
    __syncthreads();
    const XcdBarrier xbar = xcd_barrier_post((unsigned*)(p.ws + WS_BAR), xst);
    if (p.out == nullptr) grid.sync();
#define GSYNC() xcd_barrier(xbar)

    { int* tt_ = gTT_;
    if (blockIdx.x == 0 && threadIdx.x < 272) { pg8::StaticOrder S_; S_.init(MT, 2048, (int)gridDim.x, 0); pg8::Unit u_; S_.map((int)threadIdx.x, u_); tt_[u_.pm * 8 + u_.pn] = (threadIdx.x >= 256) ? (int)threadIdx.x - 255 : 0; } }

#if STOP_AFTER != 0
    { float* o_ = OUTB; for (size_t i = (size_t)blockIdx.x * 512 + threadIdx.x; i < O_END; i += (size_t)gridDim.x * 512) o_[i] = 0.f; }
#endif
    for (int rep_ = 0; rep_ < REP_P0; ++rep_)
    for (int li = 0; li < 2; ++li) { const int l = 1 - li; unsigned char* wl = WSB + (size_t)l * SZ_LAYER;
        convw(L, ldarg(I_WDN) + (size_t)l * DFF * 2048, 2048, DFF, 2048, (bf16_t*)(wl + OFF_WDN), 0);
        convw(L, ldarg(I_WUP) + (size_t)l * 2048 * DFF2, DFF2, 2048, DFF2, (bf16_t*)(wl + OFF_WUP), 0);
        convw(L, ldarg(I_WCO) + (size_t)l * 512 * 2048, 2048, 512, 2048, (bf16_t*)(wl + OFF_WCO), 0);
        convw(L, ldarg(I_WCQ) + (size_t)l * 2048 * 512, 512, 2048, 512, (bf16_t*)(wl + OFF_WCQ), 0);
        convw(L, ldarg(I_WOUT) + (size_t)l * 2048 * 2048, 2048, 2048, 2048, (bf16_t*)(wl + OFF_WOUT), 0);
        convw(L, ldarg(I_WCKV) + (size_t)l * 2048 * 1024, 1024, 2048, 1024, (bf16_t*)(wl + OFF_WCKV), 0);
        convw(L, ldarg(I_WIN) + (size_t)l * 2048 * 7176, 7176, 2048, 7168, (bf16_t*)(wl + OFF_WIN), 1);
        float* WG = (float*)(wl + OFF_WG); const float* win = ldarg(I_WIN) + (size_t)l * 2048 * 7176;
        for (int i = blockIdx.x * 512 + threadIdx.x; i < 8 * 2048; i += gridDim.x * 512) { const int j = i >> 11, k = i & 2047; WG[i] = win[(size_t)k * 7176 + 3072 + j]; }
        norm_phase(L, nullptr, nullptr, (float*)ldarg(I_MEM), ldarg(I_GMEM) + l * DM, (bf16_t*)(WSB + WS_HMEM) + (size_t)l * 256 * 2048, nullptr, 256, 0, nullptr, nullptr, nullptr, nullptr, nullptr);
    }
    GSYNC();
#if STOP_AFTER == 1
        return;
#endif
    for (int l = 0; l < 2; ++l) {
        EpiGen E{(bf16_t*)(WSB + WS_MKV) + (size_t)l * 256 * 1024, 1024, 0};
        run_gemm(L, (const bf16_t*)(WSB + WS_HMEM) + (size_t)l * 256 * 2048, (const bf16_t*)(WSB + (size_t)l * SZ_LAYER + OFF_WCKV), 256, 1024, 2048, E, -1, 0, l == 0 ? 0 : (int)gridDim.x - 4);
    }
    for (int l = 0; l < 2; ++l) {
        unsigned char* wl = WSB + (size_t)l * SZ_LAYER;
        norm_phase(L, ldarg(I_XP), ldarg(I_XS), gX_, ldarg(I_GMIX) + l * DM, gH_, nullptr, MT, (l == 0 ? 1 : 0) | 2, (const float*)(wl + OFF_WG), ldarg(I_BI) + l * 4, ldarg(I_BF) + l * 4, gIG_, gLF_, gTT_, gPART_, l == 0 ? 0 : 11, l == 0 ? 8 : 0);
        GSYNC();
#if STOP_AFTER == 2
        return;
#endif
        { EpiGen E{gZ_, NZ, 1};
          for (int rep_ = 0; rep_ < REP_GI; ++rep_) run_gemm(L, gH_, (const bf16_t*)(wl + OFF_WIN), MT, NZ, 2048, E); }
        GSYNC();
#if STOP_AFTER == 3
#ifdef DUMP3
        { const size_t gt_ = (size_t)blockIdx.x * 512 + threadIdx.x, nt_ = (size_t)gridDim.x * 512;
          for (size_t i = gt_; i < 34816; i += nt_) { OUTB[i] = gIG_[i]; OUTB[40000 + i] = gLF_[i]; }
          for (size_t i = gt_; i < 15000000; i += nt_) OUTB[100000 + i] = __uint_as_float(((unsigned)gZ_[4 * i + (i & 3)]) << 16); }
#endif
        return;
#endif
        for (int r = 0; r < 7; ++r) {
            const int bx = (int)blockIdx.x; int i;
            if (r < 6) i = r * 256 + ((r & 1) ? 255 - bx : bx);
            else { const int bb = bx - 96; if (bb < 0 || bb >= 96) break; i = 1536 + bb; }
            if (i < 1088) {
                if (i < 64) { const int b = i >> 3, h = i & 7; attn_unit<true>(L, 1, l, b, h, gZ_ + (size_t)(8192 + b * 64) * NZ + 4096 + h * 128, NZ, gZ_, nullptr, ldarg(I_CAK), ldarg(I_CAV), ldarg(I_REL) + (size_t)(l * 8 + h) * 513, gMIX_ + (size_t)(8192 + b * 64) * DM + 1024 + h * 128, DM); }
                else { const int c = (i < 1024) ? 8 + ((i - 64) >> 3) : 7 - ((i - 1024) >> 3), h = i & 7; attn_unit<true>(L, 0, l, c, h, gZ_ + (size_t)(c * 64) * NZ + 4096 + h * 128, NZ, gZ_, nullptr, nullptr, nullptr, ldarg(I_REL) + (size_t)(l * 8 + h) * 513, gMIX_ + (size_t)(c * 64) * DM + 1024 + h * 128, DM); }
            } else { const int j = i - 1088; mlstm_pa(L, j >> 2, j & 3, gZ_, gIG_, gLF_, gCD_, gDN_, gBL_, gGMAX_); }
        }
        GSYNC();
#if STOP_AFTER == 4
#ifdef DUMP4
        { const size_t gt_ = (size_t)blockIdx.x * 512 + threadIdx.x, nt_ = (size_t)gridDim.x * 512;
          for (size_t i = gt_; i < 544; i += nt_) { OUTB[i] = gBL_[i]; OUTB[1000 + i] = gGMAX_[i]; }
#if DUMP4 == 1
          for (size_t i = gt_; i < 544 * 256; i += nt_) OUTB[2000 + i] = gDN_[i];
#endif
#if DUMP4 == 2
          for (size_t i = gt_; i < 15000000; i += nt_) OUTB[200000 + i] = __uint_as_float(((unsigned)gCD_[2 * i + (i & 1)]) << 16);
#endif
        }
#endif
        return;
#endif
        mlstm_scan(L, l, gBL_, gGMAX_, gMENT_, gCD_, gDN_, gNENT_, ldarg(I_SC), ldarg(I_SN), ldarg(I_SM), OUTB);
        copy_bf_f32(gZ_ + (size_t)7680 * NZ + 5120, NZ, OUTB + O_PK + (size_t)l * 512 * 1024, 1024, 512, 128);
        copy_bf_f32(gZ_ + (size_t)7680 * NZ + 6144, NZ, OUTB + O_PV + (size_t)l * 512 * 1024, 1024, 512, 128);
        copy_bf_f32(gZ_ + (size_t)8192 * NZ + 5120, NZ, OUTB + O_SK + (size_t)l * 512 * 1024, 1024, 512, 128);
        copy_bf_f32(gZ_ + (size_t)8192 * NZ + 6144, NZ, OUTB + O_SV + (size_t)l * 512 * 1024, 1024, 512, 128);
        GSYNC();
#if STOP_AFTER == 5
        return;
#endif
        for (int rep_ = 0; rep_ < REP_PC; ++rep_)
        for (int u = blockIdx.x; u < NCS * 4; u += gridDim.x) mlstm_pc(L, u >> 2, u & 3, gZ_, gIG_, gLF_, gCD_, gNENT_, gMENT_, ldarg(I_GHEAD) + l * 1024, gMIX_);
        GSYNC();
#if STOP_AFTER == 6
        return;
#endif
        { EpiRes E{gX_, 0, nullptr}; run_gemm(L, gMIX_, (const bf16_t*)(wl + OFF_WOUT), MT, 2048, 2048, E, 256, 0); EpiRes E2{gX_, 8, gPART_}; run_gemm(L, gMIX_, (const bf16_t*)(wl + OFF_WOUT), MT, 2048, 2048, E2, 256, 8); }
        GSYNC();
#if STOP_AFTER == 7
        return;
#endif
        for (int rep_ = 0; rep_ < REP_NB; ++rep_)
        norm_phase(L, nullptr, nullptr, gX_, ldarg(I_GCROSS) + l * DM, gH_, nullptr, MT, 0, nullptr, nullptr, nullptr, nullptr, nullptr, gTT_, gPART_, 8);
        GSYNC();
#if STOP_AFTER == 8
        return;
#endif
        { EpiRes E{nullptr, -1, (float*)(WSB + WS_QCF)}; run_gemm(L, gH_, (const bf16_t*)(wl + OFF_WCQ), MT, 512, 2048, E, 0, 2); }
        GSYNC();
#if STOP_AFTER == 9
        return;
#endif
        for (int rep_ = 0; rep_ < REP_XA; ++rep_)
        for (int u = blockIdx.x; u < NCS * 4; u += gridDim.x) { const int cr = u >> 2, h = u & 3;
            if (cr < 128) attn_unit<false>(L, 2, l, cr, h, gQC_ + (size_t)(cr * 64) * 512 + h * 128, 512, nullptr, (const bf16_t*)(WSB + WS_MKV) + (size_t)l * 256 * 1024, nullptr, nullptr, nullptr, gOC_ + (size_t)(cr * 64) * 512 + h * 128, 512, (const float*)(WSB + WS_QCF) + (size_t)(cr * 64) * 512 + h * 128);
            else attn_unit<false>(L, 3, l, cr - 128, h, gQC_ + (size_t)(cr * 64) * 512 + h * 128, 512, nullptr, nullptr, ldarg(I_CMK), ldarg(I_CMV), nullptr, gOC_ + (size_t)(cr * 64) * 512 + h * 128, 512, (const float*)(WSB + WS_QCF) + (size_t)(cr * 64) * 512 + h * 128); }
        GSYNC();
#if STOP_AFTER == 10
        return;
#endif
        { EpiRes E{gX_, 0, nullptr}; run_gemm(L, gOC_, (const bf16_t*)(wl + OFF_WCO), MT, 2048, 512, E, 256, 0); EpiRes E2{gX_, 2, gPART_}; run_gemm(L, gOC_, (const bf16_t*)(wl + OFF_WCO), MT, 2048, 512, E2, 256, 2); }
        GSYNC();
#if STOP_AFTER == 11
        return;
#endif
        norm_phase(L, nullptr, nullptr, gX_, ldarg(I_GFFN) + l * DM, gH_, nullptr, MT, 0, nullptr, nullptr, nullptr, nullptr, nullptr, gTT_, gPART_, 2);
        GSYNC();
#if STOP_AFTER == 12
        return;
#endif
        { EpiGen E{gU_, DFF2, 0}; for (int rep_ = 0; rep_ < REP_GU; ++rep_) run_gemm(L, gH_, (const bf16_t*)(wl + OFF_WUP), MT, DFF2, 2048, E); }
        GSYNC();
#if STOP_AFTER == 13
        return;
#endif
        for (int rep_ = 0; rep_ < REP_CV; ++rep_)
        copy_bf_f32((const bf16_t*)(WSB + WS_MKV) + (size_t)l * 256 * 1024, 1024, OUTB + O_PMK + (size_t)l * 256 * 512, 512, 256, 64);
        copy_bf_f32((const bf16_t*)(WSB + WS_MKV) + (size_t)l * 256 * 1024 + 512, 1024, OUTB + O_PMV + (size_t)l * 256 * 512, 512, 256, 64);
        copy_bf_f32(gU_ + (size_t)8190 * DFF2, DFF2, OUTB + O_PCONV + (size_t)l * 2 * DFF2, DFF2, 2, DFF2 / 8);
        for (int b = 0; b < 8; ++b) copy_bf_f32(gU_ + (size_t)(8192 + b * 64 + 62) * DFF2, DFF2, OUTB + O_SCONV + (size_t)(l * 16 + b * 2) * DFF2, DFF2, 2, DFF2 / 8);
        conv_phase(l, gU_, ldarg(I_CONVW) + (size_t)l * 3 * DFF2, ldarg(I_CONVB) + (size_t)l * DFF2, ldarg(I_SCONV) + (size_t)l * 16 * DFF2, gACT_);
        GSYNC();
#if STOP_AFTER == 14
        return;
#endif
        { EpiRes E{gX_, 0, nullptr}; run_gemm(L, gACT_, (const bf16_t*)(wl + OFF_WDN), MT, 2048, DFF, E, 256, 0); EpiRes E2{gX_, 11, gPART_}; run_gemm(L, gACT_, (const bf16_t*)(wl + OFF_WDN), MT, 2048, DFF, E2, 256, 11); }
        GSYNC();
#if STOP_AFTER == 15
        return;
#endif
    }
    norm_phase(L, nullptr, nullptr, gX_, ldarg(I_GFINAL), nullptr, OUTB, MT, 4, nullptr, nullptr, nullptr, nullptr, nullptr, gTT_, gPART_, 11);
}

extern "C" void kernel_launch(void* const* d_in, const int* in_sizes, int n_in, void* d_out, int out_size, void* d_ws, size_t ws_size, hipStream_t stream) {
    static int grid_blocks = 0;
    if (grid_blocks == 0) {
        if (n_in != 29 || (size_t)out_size != O_END || ws_size < WS_END) { fprintf(stderr, "kernel_launch: unexpected sizes n_in %d out %d ws %zu (need %zu)\n", n_in, out_size, ws_size, (size_t)WS_END); grid_blocks = -1; return; }
        int dev = 0, cus = 0, per_cu = 0;
        hipGetDevice(&dev); hipDeviceGetAttribute(&cus, hipDeviceAttributeMultiprocessorCount, dev);
        hipFuncSetAttribute((const void*)mega, hipFuncAttributeMaxDynamicSharedMemorySize, LDS_BYTES);
        hipOccupancyMaxActiveBlocksPerMultiprocessor(&per_cu, (const void*)mega, 512, LDS_BYTES);
        if (per_cu < 1) { fprintf(stderr, "kernel_launch: occupancy query says %d blocks per CU\n", per_cu); per_cu = 1; }
        (void)hipGetLastError();
        grid_blocks = 256;
        if (cus * per_cu < 256) fprintf(stderr, "kernel_launch: this kernel needs 256 co-resident workgroups, the device offers %d\n", cus * per_cu);
    }
    if (grid_blocks < 0) return;
    if (hipMemsetAsync((char*)d_ws + WS_BAR, 0, 16384, stream) != hipSuccess) return;
    Params p{};
    for (int i = 0; i < 29; ++i) p.in[i] = (const float*)d_in[i];
    p.out = (float*)d_out; p.ws = (unsigned char*)d_ws;
    void* args[] = {&p};
    hipError_t e = hipLaunchCooperativeKernel((const void*)mega, dim3(grid_blocks), dim3(512), args, LDS_BYTES, stream);
    if (e != hipSuccess) fprintf(stderr, "cooperative launch failed: %s (grid %d)\n", hipGetErrorString(e), grid_blocks);
}
```

```cpp
#include <hip/hip_runtime.h>
#include <hip/hip_cooperative_groups.h>
#include <cstdio>
namespace cg = cooperative_groups;

namespace pg8 {
#define PG8_LAS __attribute__((address_space(3)))
typedef unsigned short bf16_t;
typedef short bf16x8 __attribute__((ext_vector_type(8)));
typedef float f32x4 __attribute__((ext_vector_type(4)));
typedef unsigned u32x4 __attribute__((ext_vector_type(4)));
constexpr int BM = 256, BK = 64, HALF = 128, HTB = HALF * BK * 2  , STAGE_BYTES = 8 * HTB, NXCD = 8, WGM = 8;

__host__ __device__ __forceinline__ int lds_byte(int r, int c) { const int st = (r >> 4) * 2 + (c >> 5), rr = r & 15, cc = c & 31, ob = rr * 64 + cc * 2; return st * 1024 + (ob ^ (((ob >> 9) & 1) << 5)); }
__host__ __device__ __forceinline__ void stage_rc(int b, int& R, int& C) { const int st = b / 1024, sb = b % 1024, swz = sb ^ (((sb >> 9) & 1) << 5); R = (st >> 1) * 16 + swz / 64; C = (st & 1) * 32 + (swz % 64) / 2; }
__host__ __device__ __forceinline__ int perm32(int rho) { const int n = rho >> 4, i = rho & 15; return 8 * (i >> 2) + 4 * n + (i & 3); }

struct Unit { int pm, pn, kc, slot; };
struct Gemm { const bf16_t* A; const bf16_t* Bt; int M, N, K, ldk; };

struct StaticOrder {
    int nM, nN, nwg, G, c, lim, S;
    __host__ __device__ __forceinline__ void init(int M, int N, int G_, int c_) { nM = M / BM; nN = N / BM; nwg = nM * nN; G = G_; c = c_; lim = nwg; S = 0; }
    __host__ __device__ __forceinline__ void map(int wgid, Unit& u) const { { const int q = nwg / NXCD, r = nwg % NXCD, xcd = wgid % NXCD, off = wgid / NXCD; wgid = (xcd < r ? xcd * (q + 1) : r * (q + 1) + (xcd - r) * q) + off; }
        const int nig = WGM * nN, gid = wgid / nig, fm = gid * WGM, gsz = (nM - fm) < WGM ? (nM - fm) : WGM;
        u.pm = fm + ((wgid % nig) % gsz); u.pn = (wgid % nig) / gsz; }
    __host__ __device__ __forceinline__ bool next(int i, Unit& u) const {
        if (S > 0) { const int nt_ = nwg - lim; if (i > 0 || c >= nt_ * S) return false; map(lim + (c % nt_), u); u.kc = c / nt_; u.slot = c % nt_; return true; }
        const long L = (long)i * G + c; if (L >= lim) return false; u.kc = 0; u.slot = 0;
        int wgid = (int)L; { const int q = nwg / NXCD, r = nwg % NXCD, xcd = wgid % NXCD, off = wgid / NXCD; wgid = (xcd < r ? xcd * (q + 1) : r * (q + 1) + (xcd - r) * q) + off; }
        const int nig = WGM * nN, gid = wgid / nig, fm = gid * WGM, gsz = (nM - fm) < WGM ? (nM - fm) : WGM;
        u.pm = fm + ((wgid % nig) % gsz); u.pn = (wgid % nig) / gsz; return true;
    }
    __device__ __forceinline__ void a_ready(const Unit&) const {}
    __device__ __forceinline__ void done(const Unit&) const {}
};
typedef __bf16 bf16v2_t __attribute__((ext_vector_type(2)));
__device__ __forceinline__ unsigned cvt_pk_bf16(float lo, float hi) { bf16v2_t v; v[0] = (__bf16)lo; v[1] = (__bf16)hi; return __builtin_bit_cast(unsigned, v); }
template <class Epi, class Sched, bool STAMP = false>
__device__ __forceinline__ void gemm_phase(PG8_LAS unsigned char* lds, const Gemm g, const Sched& S, const Epi& E, unsigned long long* stamps) {
    int tid_ = threadIdx.x; asm volatile("" : "+v"(tid_)); const int tid = tid_, wid = __builtin_amdgcn_readfirstlane(tid >> 6), lane = tid & 63, wr = wid >> 2, wc = wid & 3, fr = lane & 15, fq = lane >> 4;
    const int K = g.ldk, nt = g.K / BK; const size_t kcb = (size_t)g.K * 2;
    int ts_lo = 0, ts_hi = 0, nts = 0; const unsigned long long rt_entry = STAMP ? (unsigned long long)wall_clock64() : 0ull;
#define PG8_STAMP() do { if (STAMP && wid == 0 && nts < 64) { const unsigned long long _c = (unsigned long long)clock64(); \
        ts_lo = (lane == nts) ? (int)(unsigned)_c : ts_lo; ts_hi = (lane == nts) ? (int)(unsigned)(_c >> 32) : ts_hi; ++nts; } } while (0)
    PG8_STAMP();
    unsigned voffA[2], voffB[2];
#pragma unroll
    for (int i = 0; i < 2; ++i) { int R, C; stage_rc(tid * 16 + i * 8192, R, C); const int Rb = Epi::PERM ? ((R & ~31) + perm32(R & 31)) : R;
        voffA[i] = (unsigned)(R * K + C) * 2u; voffB[i] = (unsigned)(Rb * K + C) * 2u; }
    const size_t kstep = (size_t)(BK * 2);
    const size_t hstep = (size_t)HALF * K * 2;
    const size_t tstep = 2 * hstep;
    const unsigned ldsw = (unsigned)wid * 1024u;
    const int aoff = lds_byte(wr * 64 + fr, fq * 8), boff = lds_byte(wc * 32 + fr, fq * 8);
#define PG8_SA(b, h) (((b) * 2 + (h)) * HTB)
#define PG8_SB(b, h) ((4 + (b) * 2 + (h)) * HTB)
#define PG8_STAGE(bufoff, gbase, voff) do { _Pragma("unroll") for (int _i = 0; _i < 2; ++_i) \
        __builtin_amdgcn_global_load_lds((const unsigned*)((const char*)(gbase) + (voff)[_i]), (PG8_LAS unsigned*)(lds + (bufoff) + ldsw + _i * 8192), 16, 0, 0); } while (0)
#define PG8_LDA(dst, b, h) do { _Pragma("unroll") for (int m = 0; m < 4; ++m) _Pragma("unroll") for (int k = 0; k < 2; ++k) dst[m][k] = *(const PG8_LAS bf16x8*)(lds + PG8_SA(b, h) + aoff + m * 2048 + k * 1024); } while (0)
#define PG8_LDB(dst, b, h) do { _Pragma("unroll") for (int n = 0; n < 2; ++n) _Pragma("unroll") for (int k = 0; k < 2; ++k) dst[n][k] = *(const PG8_LAS bf16x8*)(lds + PG8_SB(b, h) + boff + n * 2048 + k * 1024); } while (0)
#define PG8_MMA(ai, bj, At, Bt) do { __builtin_amdgcn_s_setprio(1); _Pragma("unroll") for (int m = 0; m < 4; ++m) _Pragma("unroll") for (int n = 0; n < 2; ++n) _Pragma("unroll") for (int k = 0; k < 2; ++k) \
        acc[ai][bj][m][n] = __builtin_amdgcn_mfma_f32_16x16x32_bf16(Bt[n][k], At[m][k], acc[ai][bj][m][n], 0, 0, 0); __builtin_amdgcn_s_setprio(0); } while (0)
#define PG8_WAIT_V(n) asm volatile("s_waitcnt vmcnt(" #n ")" ::: "memory")
#define PG8_WAIT_L(n) asm volatile("s_waitcnt lgkmcnt(" #n ")" ::: "memory")
#define PG8_BAR __builtin_amdgcn_s_barrier()
#define PG8_SCHED __builtin_amdgcn_sched_barrier(0)
    Unit cur, nxt; int ui = 0;
    if (!S.next(0, cur)) return;
    f32x4 acc[2][2][4][2];
#pragma unroll
    for (int a = 0; a < 2; ++a)
#pragma unroll
        for (int b = 0; b < 2; ++b)
#pragma unroll
            for (int m = 0; m < 4; ++m)
#pragma unroll
                for (int n = 0; n < 2; ++n) acc[a][b][m][n] = (f32x4){0.f, 0.f, 0.f, 0.f};
    bf16x8 At[4][2], B0[2][2], B1[2][2];
    const char* cA = (const char*)g.A + (size_t)cur.pm * tstep + (size_t)cur.kc * kcb; const char* cB = (const char*)g.Bt + (size_t)cur.pn * tstep + (size_t)cur.kc * kcb;
    S.a_ready(cur);
    PG8_STAGE(PG8_SB(0, 0), cB, voffB); PG8_STAGE(PG8_SB(0, 1), cB + hstep, voffB); PG8_STAGE(PG8_SA(0, 0), cA, voffA); PG8_STAGE(PG8_SA(0, 1), cA + hstep, voffA);
    if (wr == 1) PG8_BAR;
    PG8_WAIT_V(2); PG8_BAR;
    PG8_STAGE(PG8_SB(1, 0), cB + kstep, voffB); PG8_STAGE(PG8_SA(1, 0), cA + kstep, voffA); PG8_STAGE(PG8_SB(1, 1), cB + hstep + kstep, voffB);
    PG8_WAIT_V(6); PG8_BAR;
    PG8_STAMP();
    for (;;) {
        const bool has_next = S.next(ui + 1, nxt);
        const char* nA = has_next ? (const char*)g.A + (size_t)nxt.pm * tstep + (size_t)nxt.kc * kcb : cA; const char* nB = has_next ? (const char*)g.Bt + (size_t)nxt.pn * tstep + (size_t)nxt.kc * kcb : cB;
        for (int t = 0; t < nt; t += 2) {
            const bool last = (t == nt - 2);
            const char* a1 = cA + (size_t)(t + 1) * kstep;
            const char* a2 = last ? nA : cA + (size_t)(t + 2) * kstep; const char* b2 = last ? nB : cB + (size_t)(t + 2) * kstep;
            const char* a3 = a2 + kstep; const char* b3 = b2 + kstep;
            if (last && has_next) S.a_ready(nxt);
            PG8_LDB(B0, 0, 0); PG8_LDB(B1, 0, 1); PG8_SCHED; PG8_LDA(At, 0, 0); PG8_STAGE(PG8_SA(1, 1), a1 + hstep, voffA);
            PG8_WAIT_V(8); PG8_WAIT_L(0); PG8_BAR; PG8_MMA(0, 0, At, B0); PG8_MMA(0, 1, At, B1); PG8_BAR; PG8_SCHED;
            PG8_LDA(At, 0, 1); PG8_STAGE(PG8_SB(0, 0), b2, voffB); PG8_STAGE(PG8_SB(0, 1), b2 + hstep, voffB); PG8_STAGE(PG8_SA(0, 0), a2, voffA);
            PG8_WAIT_V(8); PG8_WAIT_L(0); PG8_BAR; PG8_MMA(1, 0, At, B0); PG8_MMA(1, 1, At, B1); PG8_BAR; PG8_SCHED;
            PG8_LDB(B0, 1, 0); PG8_LDB(B1, 1, 1); PG8_SCHED; PG8_LDA(At, 1, 0); PG8_STAGE(PG8_SA(0, 1), a2 + hstep, voffA);
            PG8_WAIT_V(8); PG8_WAIT_L(0); PG8_BAR; PG8_MMA(0, 0, At, B0); PG8_MMA(0, 1, At, B1); PG8_BAR; PG8_SCHED;
            PG8_LDA(At, 1, 1); PG8_STAGE(PG8_SB(1, 0), b3, voffB); PG8_STAGE(PG8_SB(1, 1), b3 + hstep, voffB); PG8_STAGE(PG8_SA(1, 0), a3, voffA);
            PG8_WAIT_V(8); PG8_WAIT_L(0); PG8_BAR; PG8_MMA(1, 0, At, B0); PG8_MMA(1, 1, At, B1); PG8_BAR; PG8_SCHED;
        }
        PG8_STAMP();
        if (wr == 0) PG8_BAR;
        if constexpr (!Epi::AFTER_DRAIN) { E(acc, cur, wr, wc, fr, fq); S.done(cur); }
        PG8_STAMP();
        if (!has_next) break;
#pragma unroll
        for (int a = 0; a < 2; ++a)
#pragma unroll
            for (int b = 0; b < 2; ++b)
#pragma unroll
                for (int m = 0; m < 4; ++m)
#pragma unroll
                    for (int n = 0; n < 2; ++n) acc[a][b][m][n] = (f32x4){0.f, 0.f, 0.f, 0.f};
        cur = nxt; cA = nA; cB = nB; ++ui;
        if (wr == 1) PG8_BAR;
    }
    PG8_WAIT_V(0);
    PG8_BAR;
    if constexpr (Epi::AFTER_DRAIN) { E.fused(acc, cur, wr, wc, fr, fq, lds, wid, lane); S.done(cur); }
    PG8_STAMP();
    if (STAMP && wid == 0) { stamps[lane] = lane < nts ? (((unsigned long long)(unsigned)ts_hi << 32) | (unsigned)ts_lo) : 0ull;
        if (lane == 62) stamps[62] = rt_entry; if (lane == 63) stamps[63] = (unsigned long long)wall_clock64(); }
#undef PG8_STAMP
#undef PG8_SA
#undef PG8_SB
#undef PG8_STAGE
#undef PG8_LDA
#undef PG8_LDB
#undef PG8_MMA
#undef PG8_WAIT_V
#undef PG8_WAIT_L
#undef PG8_BAR
#undef PG8_SCHED
}
}

using pg8::bf16_t; using pg8::bf16x8; using pg8::f32x4; using pg8::cvt_pk_bf16;
#define LAS __attribute__((address_space(3)))
typedef unsigned u32x2 __attribute__((ext_vector_type(2)));
typedef unsigned u32x4 __attribute__((ext_vector_type(4)));

constexpr int DM = 2048, MT = 8704, NZ = 7168, DFF = 5632, DFF2 = 11264, NCS = 136;
constexpr int LDS_BYTES = 131072 + 16;
#ifndef STOP_AFTER
#define STOP_AFTER 0
#endif
#ifndef REP_P0
#define REP_P0 1
#endif
#ifndef REP_GI
#define REP_GI 1
#endif
#ifndef REP_GU
#define REP_GU 1
#endif
#ifndef REP_PA
#define REP_PA 1
#endif
#ifndef REP_AT
#define REP_AT 1
#endif
#ifndef REP_PC
#define REP_PC 1
#endif
#ifndef REP_XA
#define REP_XA 1
#endif
#ifndef REP_CV
#define REP_CV 1
#endif
#ifndef REP_NB
#define REP_NB 1
#endif

constexpr size_t SZ_WIN = 7168ull * 2048 * 2, SZ_WOUT = 2048ull * 2048 * 2, SZ_WCQ = 512ull * 2048 * 2, SZ_WCKV = 1024ull * 2048 * 2,
                 SZ_WCO = 2048ull * 512 * 2, SZ_WUP = 11264ull * 2048 * 2, SZ_WDN = 2048ull * 5632 * 2, SZ_WG = 8ull * 2048 * 4;
constexpr size_t OFF_WIN = 0, OFF_WOUT = OFF_WIN + SZ_WIN, OFF_WCQ = OFF_WOUT + SZ_WOUT, OFF_WCKV = OFF_WCQ + SZ_WCQ, OFF_WCO = OFF_WCKV + SZ_WCKV,
                 OFF_WUP = OFF_WCO + SZ_WCO, OFF_WDN = OFF_WUP + SZ_WUP, OFF_WG = OFF_WDN + SZ_WDN, SZ_LAYER = OFF_WG + SZ_WG;
constexpr size_t WS_X = 2 * SZ_LAYER;
constexpr size_t WS_H = WS_X + (size_t)MT * DM * 4;
constexpr size_t WS_HMEM = WS_H + (size_t)MT * DM * 2;
constexpr size_t WS_MKV = WS_HMEM + 2ull * 256 * 2048 * 2;
constexpr size_t WS_D = WS_MKV + 2ull * 256 * 1024 * 2;
constexpr size_t WS_Z = WS_D, WS_CD = WS_D + (size_t)MT * NZ * 2, WS_U = WS_D;
constexpr size_t WS_E = WS_D + (size_t)MT * DFF2 * 2;
constexpr size_t WS_MIX = WS_E, WS_QC = WS_E, WS_OC = WS_E + 16ull * 1024 * 1024, WS_ACT = WS_E, WS_QCF = WS_E + 32ull * 1024 * 1024;
constexpr size_t WS_S = WS_E + (size_t)MT * DFF * 2;
constexpr size_t WS_IG = WS_S, WS_LF = WS_IG + (size_t)MT * 4 * 4, WS_BL = WS_LF + (size_t)MT * 4 * 4, WS_GMAX = WS_BL + 4096, WS_MENT = WS_GMAX + 4096,
                 WS_DN = WS_MENT + 4096, WS_NENT = WS_DN + (size_t)NCS * 4 * 256 * 4, WS_BAR = WS_NENT + (size_t)NCS * 4 * 256 * 4, WS_TT = WS_BAR + 16384, WS_END = WS_TT + 4096;
static_assert(WS_CD + (size_t)NCS * 4 * 65536 * 2 <= WS_E, "region D");

constexpr size_t O_YP = 0, O_YS = O_YP + 8192ull * 2048, O_PC = O_YS + 512ull * 2048, O_PN = O_PC + 2ull * 4 * 65536, O_PM = O_PN + 2 * 4 * 256,
                 O_PK = O_PM + 8, O_PV = O_PK + 2ull * 512 * 1024, O_PMK = O_PV + 2ull * 512 * 1024, O_PMV = O_PMK + 2ull * 256 * 512,
                 O_PCONV = O_PMV + 2ull * 256 * 512, O_SC = O_PCONV + 2ull * 2 * DFF2, O_SN = O_SC + 2ull * 8 * 4 * 65536, O_SM = O_SN + 2ull * 8 * 4 * 256,
                 O_SK = O_SM + 64, O_SV = O_SK + 2ull * 8 * 64 * 1024, O_SCONV = O_SV + 2ull * 8 * 64 * 1024, O_END = O_SCONV + 2ull * 8 * 2 * DFF2;

struct Params { const float* in[29]; float* out; unsigned char* ws; };
enum { I_XP = 0, I_XS, I_MEM, I_CAK, I_CAV, I_CMK, I_CMV, I_SC, I_SN, I_SM, I_SCONV, I_GMIX, I_WIN, I_BI, I_BF, I_GHEAD, I_REL, I_WOUT, I_GCROSS, I_GMEM, I_WCQ, I_WCKV,
       I_WCO, I_GFFN, I_WUP, I_CONVW, I_CONVB, I_WDN, I_GFINAL };

__device__ __forceinline__ int otid() { int t = threadIdx.x; asm volatile("" : "+v"(t)); return t; }
__device__ __forceinline__ int obid() { int t = blockIdx.x; asm volatile("" : "+s"(t)); return t; }
__device__ __forceinline__ unsigned short f2bf(float f) { unsigned u = __float_as_uint(f); u += 0x7FFFu + ((u >> 16) & 1u); return (unsigned short)(u >> 16); }
__device__ __forceinline__ float bflo(unsigned w) { return __uint_as_float(w << 16); }
__device__ __forceinline__ float bfhi(unsigned w) { return __uint_as_float(w & 0xffff0000u); }
__device__ __forceinline__ f32x4 mfma16(bf16x8 a, bf16x8 b, f32x4 c) { return __builtin_amdgcn_mfma_f32_16x16x32_bf16(a, b, c, 0, 0, 0); }
__device__ __forceinline__ u32x4 ld8(const void* p, size_t eoff, bool isf) {
    if (isf) { const float* f = (const float*)p + eoff; const f32x4 a = *(const f32x4*)f, b = *(const f32x4*)(f + 4);
        u32x4 w; w.x = cvt_pk_bf16(a[0], a[1]); w.y = cvt_pk_bf16(a[2], a[3]); w.z = cvt_pk_bf16(b[0], b[1]); w.w = cvt_pk_bf16(b[2], b[3]); return w; }
    return *(const u32x4*)((const bf16_t*)p + eoff);
}
__device__ __forceinline__ void st_tr8(LAS unsigned short* T, int ldt, int c8, int r, u32x4 w) {
    T[(c8 + 0) * ldt + r] = (unsigned short)(w.x & 0xffffu); T[(c8 + 1) * ldt + r] = (unsigned short)(w.x >> 16);
    T[(c8 + 2) * ldt + r] = (unsigned short)(w.y & 0xffffu); T[(c8 + 3) * ldt + r] = (unsigned short)(w.y >> 16);
    T[(c8 + 4) * ldt + r] = (unsigned short)(w.z & 0xffffu); T[(c8 + 5) * ldt + r] = (unsigned short)(w.z >> 16);
    T[(c8 + 6) * ldt + r] = (unsigned short)(w.w & 0xffffu); T[(c8 + 7) * ldt + r] = (unsigned short)(w.w >> 16);
}
__device__ __forceinline__ float wsum(float v) { v += __shfl_xor(v, 1); v += __shfl_xor(v, 2); v += __shfl_xor(v, 4); v += __shfl_xor(v, 8); v += __shfl_xor(v, 16); v += __shfl_xor(v, 32); return v; }

__device__ __forceinline__ void convw(LAS unsigned char* L, const float* __restrict__ src, int ld, int K, int N, bf16_t* __restrict__ dst, int skip) {
    LAS unsigned short* T = (LAS unsigned short*)L;
    const int tid = otid(), nkt = K >> 6, ntl = nkt * (N >> 6);
    const int kk = tid >> 4, n4 = (tid & 15) * 4;
    int t = blockIdx.x; if (t >= ntl) return;
    f32x4 v[2];
    { const int kt = t % nkt, nt = t / nkt, k0 = kt * 64, n0 = nt * 64, nsrc = n0 + ((skip && n0 >= 3072) ? 8 : 0);
#pragma unroll
      for (int hf = 0; hf < 2; ++hf) v[hf] = __builtin_nontemporal_load((const f32x4*)(src + (size_t)(k0 + kk + hf * 32) * ld + nsrc + n4)); }
    for (; t < ntl; t += gridDim.x) {
        const int kt = t % nkt, nt = t / nkt, k0 = kt * 64, n0 = nt * 64;
#pragma unroll
        for (int hf = 0; hf < 2; ++hf) { const int k = kk + hf * 32;
            T[(n4 + 0) * 72 + k] = f2bf(v[hf][0]); T[(n4 + 1) * 72 + k] = f2bf(v[hf][1]); T[(n4 + 2) * 72 + k] = f2bf(v[hf][2]); T[(n4 + 3) * 72 + k] = f2bf(v[hf][3]); }
        __syncthreads();
        const int t2 = t + gridDim.x;
        if (t2 < ntl) { const int kt2 = t2 % nkt, nt2 = t2 / nkt, k02 = kt2 * 64, n02 = nt2 * 64, nsrc = n02 + ((skip && n02 >= 3072) ? 8 : 0);
#pragma unroll
            for (int hf = 0; hf < 2; ++hf) v[hf] = __builtin_nontemporal_load((const f32x4*)(src + (size_t)(k02 + kk + hf * 32) * ld + nsrc + n4)); }
        { const int n = tid >> 3, k8 = (tid & 7) * 8; const u32x4 w = *(LAS u32x4*)(T + n * 72 + k8); *(u32x4*)(dst + (size_t)(n0 + n) * K + k0 + k8) = w; }
        __syncthreads();
    }
}

__device__ __forceinline__ void norm_phase(LAS unsigned char* L, const float* xp, const float* xs, float* X, const float* __restrict__ g, bf16_t* H, float* yout, int rows, int mode,
                                           const float* WG, const float* bi, const float* bfg, float* IG, float* LF, const int* TT = nullptr, const float* PART = nullptr, int S = 0, int b0 = 0) {
    const int tid = otid(), lane = tid & 63, wave = tid >> 6;
    if ((int)blockIdx.x < b0) return;
    LAS float* WGs = (LAS float*)L;
    LAS int* tts = (LAS int*)(L + 65536);
    if ((mode & 2) || S > 0) { if (mode & 2) for (int i = tid; i < 8 * 2048; i += 512) WGs[i] = WG[i];
        if (S > 0 && tid < 272) tts[tid] = TT[tid];
        __syncthreads(); }
    const int rstep = ((int)gridDim.x - b0) * 8;
    int row = ((int)blockIdx.x - b0) * 8 + wave;
    f32x4 nx[8];
    if (row < rows) { const float* src = (mode & 1) ? (row < 8192 ? xp + (size_t)row * DM : xs + (size_t)(row - 8192) * DM) : X + (size_t)row * DM;
#pragma unroll
        for (int i = 0; i < 8; ++i) nx[i] = *(const f32x4*)(src + i * 256 + lane * 4); }
    for (; row < rows; row += rstep) {
        f32x4 xv[8]; float ss = 0.f;
#pragma unroll
        for (int i = 0; i < 8; ++i) { xv[i] = nx[i]; ss += xv[i][0] * xv[i][0] + xv[i][1] * xv[i][1] + xv[i][2] * xv[i][2] + xv[i][3] * xv[i][3]; }
        { const int rn = row + rstep; if (rn < rows) { const float* src = (mode & 1) ? (rn < 8192 ? xp + (size_t)rn * DM : xs + (size_t)(rn - 8192) * DM) : X + (size_t)rn * DM;
#pragma unroll
            for (int i = 0; i < 8; ++i) nx[i] = *(const f32x4*)(src + i * 256 + lane * 4); } }
        if (S > 0) { const int pm = row >> 8;
#pragma unroll
            for (int i = 0; i < 8; ++i) { const int sl = __builtin_amdgcn_readfirstlane(tts[pm * 8 + i]);
                if (sl) { const float* pp = PART + (size_t)((sl - 1) * S) * 65536 + (size_t)(row & 255) * 256 + lane * 4;
                    for (int kc = 0; kc < S; ++kc) xv[i] = xv[i] + *(const f32x4*)(pp + (size_t)kc * 65536);
                    *(f32x4*)(X + (size_t)row * DM + i * 256 + lane * 4) = xv[i]; } }
            ss = 0.f;
#pragma unroll
            for (int i = 0; i < 8; ++i) ss += xv[i][0] * xv[i][0] + xv[i][1] * xv[i][1] + xv[i][2] * xv[i][2] + xv[i][3] * xv[i][3]; }
        ss = wsum(ss);
        const float r = rsqrtf(ss * (1.0f / 2048.0f) + 1e-6f);
        if (mode & 1) {
#pragma unroll
            for (int i = 0; i < 8; ++i) *(f32x4*)(X + (size_t)row * DM + i * 256 + lane * 4) = xv[i];
        }
#pragma unroll
        for (int i = 0; i < 8; ++i) { const f32x4 gv = *(const f32x4*)(g + i * 256 + lane * 4); xv[i] = xv[i] * r * gv;
            if (mode & 4) __builtin_nontemporal_store(xv[i], (f32x4*)(yout + (size_t)row * DM + i * 256 + lane * 4));
            else { u32x2 w; w.x = cvt_pk_bf16(xv[i][0], xv[i][1]); w.y = cvt_pk_bf16(xv[i][2], xv[i][3]); *(u32x2*)(H + (size_t)row * DM + i * 256 + lane * 4) = w; } }
        if (mode & 2) {
            float z[8];
#pragma unroll
            for (int j = 0; j < 8; ++j) { float a = 0.f;
#pragma unroll
                for (int i = 0; i < 8; ++i) { const f32x4 wv = *(LAS f32x4*)(WGs + j * 2048 + i * 256 + lane * 4); a += xv[i][0] * wv[0] + xv[i][1] * wv[1] + xv[i][2] * wv[2] + xv[i][3] * wv[3]; }
                z[j] = wsum(a); asm volatile("" ::: "memory"); }
            if (lane == 0) {
#pragma unroll
                for (int j = 0; j < 4; ++j) { IG[row * 4 + j] = z[j] + bi[j]; const float f = z[4 + j] + bfg[j]; LF[row * 4 + j] = fminf(f, 0.f) - log1pf(__expf(-fabsf(f))); } }
        }
    }
    __syncthreads();
}

struct EpiRes {
    static constexpr bool PERM = false, AFTER_DRAIN = false;
    float* X; int atomic; float* part;
    __device__ __forceinline__ void operator()(const f32x4 (&acc)[2][2][4][2], const pg8::Unit& u, int wr, int wc, int fr, int fq) const {
        const int row0 = u.pm * 256 + wr * 64 + fr, col0 = u.pn * 256 + wc * 32 + 4 * fq;
        if (atomic < 0) {
            float* pb = part + (size_t)u.kc * ((size_t)MT * 512) + (size_t)row0 * 512 + col0;
#pragma unroll
            for (int ai = 0; ai < 2; ++ai)
#pragma unroll
                for (int m = 0; m < 4; ++m)
#pragma unroll
                    for (int bj = 0; bj < 2; ++bj)
#pragma unroll
                        for (int n = 0; n < 2; ++n) *(f32x4*)(pb + (size_t)(ai * 128 + m * 16) * 512 + bj * 128 + n * 16) = acc[ai][bj][m][n];
            return; }
        if (atomic) {
            float* pb = part + (size_t)(u.slot * atomic + u.kc) * 65536 + (size_t)(wr * 64 + fr) * 256 + wc * 32 + 4 * fq;
#pragma unroll
            for (int ai = 0; ai < 2; ++ai)
#pragma unroll
                for (int m = 0; m < 4; ++m)
#pragma unroll
                    for (int bj = 0; bj < 2; ++bj)
#pragma unroll
                        for (int n = 0; n < 2; ++n) *(f32x4*)(pb + (size_t)(ai * 128 + m * 16) * 256 + bj * 128 + n * 16) = acc[ai][bj][m][n];
            return; }
#pragma unroll
        for (int ai = 0; ai < 2; ++ai)
#pragma unroll
            for (int m = 0; m < 4; ++m) { float* rowp = X + (size_t)(row0 + ai * 128 + m * 16) * DM + col0;
#pragma unroll
                for (int bj = 0; bj < 2; ++bj)
#pragma unroll
                    for (int n = 0; n < 2; ++n) { f32x4* q = (f32x4*)(rowp + bj * 128 + n * 16); *q = *q + acc[ai][bj][m][n]; }
                asm volatile("" ::: "memory"); }
    }
};
struct EpiGen {
    static constexpr bool PERM = true, AFTER_DRAIN = false;
    bf16_t* O; int ldc; int mode;
    __device__ __forceinline__ void operator()(const f32x4 (&acc)[2][2][4][2], const pg8::Unit& u, int wr, int wc, int fr, int fq) const {
        const int row0 = u.pm * 256 + wr * 64 + fr, col0 = u.pn * 256 + wc * 32 + 8 * fq; const int blk = mode ? (u.pn >> 2) : 0;
#pragma unroll
        for (int ai = 0; ai < 2; ++ai)
#pragma unroll
            for (int m = 0; m < 4; ++m) { bf16_t* rowp = O + (size_t)(row0 + ai * 128 + m * 16) * ldc + col0;
#pragma unroll
                for (int bj = 0; bj < 2; ++bj) { f32x4 v0 = acc[ai][bj][m][0], v1 = acc[ai][bj][m][1];
                    if (blk == 1) { v0 = v0 * 0.0625f; v1 = v1 * 0.0625f; }
                    else if (blk == 3) {
#pragma unroll
                        for (int j = 0; j < 4; ++j) { v0[j] = __builtin_amdgcn_rcpf(1.0f + __expf(-v0[j])); v1[j] = __builtin_amdgcn_rcpf(1.0f + __expf(-v1[j])); } }
                    u32x4 w; w.x = cvt_pk_bf16(v0[0], v0[1]); w.y = cvt_pk_bf16(v0[2], v0[3]); w.z = cvt_pk_bf16(v1[0], v1[1]); w.w = cvt_pk_bf16(v1[2], v1[3]);
                    *(u32x4*)(rowp + bj * 128) = w; }
                asm volatile("" ::: "memory"); }
    }
};
__device__ __forceinline__ void copy_bf_f32(const bf16_t* src, int lds_, float* dst, int ldd, int rows, int rowg) {
    const int gt = obid() * 512 + otid(), nthr = gridDim.x * 512;
    for (int i = gt; i < rows * rowg; i += nthr) { const int r = i / rowg, c = (i - r * rowg) * 8; const u32x4 w = *(const u32x4*)(src + (size_t)r * lds_ + c);
        float* d = dst + (size_t)r * ldd + c; *(f32x4*)d = (f32x4){bflo(w.x), bfhi(w.x), bflo(w.y), bfhi(w.y)}; *(f32x4*)(d + 4) = (f32x4){bflo(w.z), bfhi(w.z), bflo(w.w), bfhi(w.w)}; }
}
template <class Epi> __device__ __forceinline__ void run_gemm(LAS unsigned char* L, const bf16_t* A, const bf16_t* Bt, int M, int N, int K, const Epi& E, int lim = -1, int split = 0, int cshift = 0) {
    pg8::Gemm g{A, Bt, M, N, split > 0 ? K / split : K, K}; pg8::StaticOrder S; S.init(M, N, (int)gridDim.x, ((int)blockIdx.x + cshift) % (int)gridDim.x); if (lim >= 0) S.lim = lim; S.S = split;
    pg8::gemm_phase<Epi, pg8::StaticOrder, false>(L, g, S, E, nullptr);
    __syncthreads();
}

typedef short s16x4 __attribute__((ext_vector_type(4)));
constexpr int AT_QS = 0, AT_KS = 17408, AT_VS = 52224, AT_BT = 89088, AT_CM = 91200, AT_CO = 91712;
__device__ __forceinline__ void kv_src(int type, int l, int c, int h, int kt, const bf16_t* Z, const bf16_t* MKV, const float* ck, const float* cv, const void*& kp, const void*& vp, int& ld, bool& isf) {
    if (type == 0) { const int cc = c - 8 + kt; kp = Z + (size_t)(cc * 64) * NZ + 5120 + h * 128; vp = (const bf16_t*)kp + 1024; ld = NZ; isf = false; }
    else if (type == 1) { if (kt < 8) { const size_t o_ = ((size_t)((l * 8 + c) * 512 + kt * 64)) * 1024 + h * 128; kp = ck + o_; vp = cv + o_; ld = 1024; isf = true; }
                          else { kp = Z + (size_t)(8192 + c * 64) * NZ + 5120 + h * 128; vp = (const bf16_t*)kp + 1024; ld = NZ; isf = false; } }
    else if (type == 2) { kp = MKV + (size_t)(kt * 64) * 1024 + h * 128; vp = (const bf16_t*)kp + 512; ld = 1024; isf = false; }
    else { const size_t o_ = ((size_t)((l * 8 + c) * 256 + kt * 64)) * 512 + h * 128; kp = ck + o_; vp = cv + o_; ld = 512; isf = true; }
}
struct Raw8 { u32x4 a, b; };
__device__ __forceinline__ Raw8 ldraw(const void* p, size_t eoff, bool isf) { Raw8 r;
    if (isf) { const float* f = (const float*)p + eoff; r.a = *(const u32x4*)f; r.b = *(const u32x4*)(f + 4); } else { r.a = *(const u32x4*)((const bf16_t*)p + eoff); r.b = r.a; } return r; }
__device__ __forceinline__ u32x4 cvraw(const Raw8& r, bool isf) {
    if (!isf) return r.a;
    u32x4 w; w.x = cvt_pk_bf16(__uint_as_float(r.a.x), __uint_as_float(r.a.y)); w.y = cvt_pk_bf16(__uint_as_float(r.a.z), __uint_as_float(r.a.w));
    w.z = cvt_pk_bf16(__uint_as_float(r.b.x), __uint_as_float(r.b.y)); w.w = cvt_pk_bf16(__uint_as_float(r.b.z), __uint_as_float(r.b.w)); return w; }
template <bool BIAS> __device__ __forceinline__ void attn_unit(LAS unsigned char* L, int type, int l, int c  , int h, const bf16_t* Q, int ldq, const bf16_t* Z, const bf16_t* MKV,
                                          const float* ck, const float* cv, const float* bias, bf16_t* O, int ldo, const float* Qf = nullptr) {
    const int tid = otid(), lane = tid & 63, w = tid >> 6, qt = w & 3, kh = w >> 2, fr = lane & 15, fq = lane >> 4;
    const int ntile = (type < 2) ? 9 : 4, tile0 = (type == 0 && c < 8) ? 8 - c : 0;
    LAS float* bt = (LAS float*)(L + AT_BT);
    const int sr0 = tid >> 4, sc8 = (tid & 15) * 8;
    __syncthreads();
#pragma unroll
    for (int i = 0; i < 2; ++i) { const int r = sr0 + i * 32;
        if (Qf) { const float* q0 = Qf + (size_t)r * 512 + sc8; const float* q1 = q0 + (size_t)MT * 512;
            const f32x4 a = *(const f32x4*)q0 + *(const f32x4*)q1, b = *(const f32x4*)(q0 + 4) + *(const f32x4*)(q1 + 4);
            u32x4 wq; wq.x = cvt_pk_bf16(a[0], a[1]); wq.y = cvt_pk_bf16(a[2], a[3]); wq.z = cvt_pk_bf16(b[0], b[1]); wq.w = cvt_pk_bf16(b[2], b[3]); *(LAS u32x4*)(L + AT_QS + (r * 136 + sc8) * 2) = wq; }
        else *(LAS u32x4*)(L + AT_QS + (r * 136 + sc8) * 2) = *(const u32x4*)(Q + (size_t)r * ldq + sc8); }
    if (BIAS) for (int i = tid; i < 513; i += 512) bt[i] = bias[i] * 1.4426950408889634f;
    {
        const void* kp; const void* vp; int ld; bool isf; kv_src(type, l, c, h, tile0, Z, MKV, ck, cv, kp, vp, ld, isf);
#pragma unroll
        for (int i = 0; i < 2; ++i) { const int r = sr0 + i * 32; const Raw8 kr = ldraw(kp, (size_t)r * ld + sc8, isf), vr = ldraw(vp, (size_t)r * ld + sc8, isf);
            *(LAS u32x4*)(L + AT_KS + (r * 136 + sc8) * 2) = cvraw(kr, isf); *(LAS u32x4*)(L + AT_VS + (r * 144 + sc8) * 2) = cvraw(vr, isf); }
    }
    __syncthreads();
    bf16x8 qf[4];
#pragma unroll
    for (int ks = 0; ks < 4; ++ks) qf[ks] = *(LAS bf16x8*)(L + AT_QS + ((qt * 16 + fr) * 136 + ks * 32 + fq * 8) * 2);
    float m_run = -1e30f, l_run = 0.f; f32x4 o[8];
#pragma unroll
    for (int i = 0; i < 8; ++i) o[i] = (f32x4){0.f, 0.f, 0.f, 0.f};
    const float scale = 0.08838834764831845f * 1.4426950408889634f;
    for (int kt = tile0; kt < ntile; ++kt) {
        const int buf = (kt - tile0) & 1; const bool more = (kt + 1 < ntile);
        Raw8 kr[2], vr[2]; bool isf = false;
        if (more) { const void* kp; const void* vp; int ld; kv_src(type, l, c, h, kt + 1, Z, MKV, ck, cv, kp, vp, ld, isf);
#pragma unroll
            for (int i = 0; i < 2; ++i) { const int r = sr0 + i * 32; kr[i] = ldraw(kp, (size_t)r * ld + sc8, isf); vr[i] = ldraw(vp, (size_t)r * ld + sc8, isf); } }
        LAS unsigned char* Kb = L + AT_KS + buf * 17408; LAS unsigned char* Vb = L + AT_VS + buf * 18432;
        f32x4 s[2];
        __builtin_amdgcn_s_setprio(1);
#pragma unroll
        for (int st = 0; st < 2; ++st) { s[st] = (f32x4){0.f, 0.f, 0.f, 0.f};
#pragma unroll
            for (int ks = 0; ks < 4; ++ks) { const bf16x8 kf = *(LAS bf16x8*)(Kb + ((kh * 32 + st * 16 + fr) * 136 + ks * 32 + fq * 8) * 2); s[st] = mfma16(kf, qf[ks], s[st]); } }
        __builtin_amdgcn_s_setprio(0);
        float mx = -1e30f;
#pragma unroll
        for (int st = 0; st < 2; ++st)
#pragma unroll
            for (int j = 0; j < 4; ++j) { float v = s[st][j] * scale;
                if (BIAS) { int rel = 512 + (qt * 16 + fr) - (kt * 64 + kh * 32 + st * 16 + fq * 4 + j); rel = rel > 256 ? 256 : rel; v += bt[rel + 256]; }
                s[st][j] = v; mx = fmaxf(mx, v); }
        mx = fmaxf(mx, __shfl_xor(mx, 16)); mx = fmaxf(mx, __shfl_xor(mx, 32));
        float alpha = 1.0f;
        if (!__all(mx - m_run <= 11.5f)) { const float m_new = fmaxf(m_run, mx); alpha = __builtin_amdgcn_exp2f(m_run - m_new); m_run = m_new;
#pragma unroll
            for (int i = 0; i < 8; ++i) o[i] = o[i] * alpha; }
        float rs = 0.f;
#pragma unroll
        for (int st = 0; st < 2; ++st)
#pragma unroll
            for (int j = 0; j < 4; ++j) { const float pv = __builtin_amdgcn_exp2f(s[st][j] - m_run); s[st][j] = pv; rs += pv; }
        l_run = l_run * alpha + rs;
        u32x4 pw; pw.x = cvt_pk_bf16(s[0][0], s[0][1]); pw.y = cvt_pk_bf16(s[0][2], s[0][3]); pw.z = cvt_pk_bf16(s[1][0], s[1][1]); pw.w = cvt_pk_bf16(s[1][2], s[1][3]);
        const bf16x8 pf = __builtin_bit_cast(bf16x8, pw);
        LAS unsigned char* vrow = Vb + ((kh * 32 + 4 * fq + (fr >> 2)) * 144 + (fr & 3) * 4) * 2;
        __builtin_amdgcn_s_setprio(1);
#pragma unroll
        for (int i = 0; i < 8; ++i) { const s16x4 v0 = __builtin_amdgcn_ds_read_tr16_b64_v4i16((LAS s16x4*)(vrow + i * 32)), v1 = __builtin_amdgcn_ds_read_tr16_b64_v4i16((LAS s16x4*)(vrow + 16 * 288 + i * 32));
            const bf16x8 vf = {v0[0], v0[1], v0[2], v0[3], v1[0], v1[1], v1[2], v1[3]}; o[i] = mfma16(vf, pf, o[i]); }
        __builtin_amdgcn_s_setprio(0);
        if (more) { LAS unsigned char* Kn = L + AT_KS + (buf ^ 1) * 17408; LAS unsigned char* Vn = L + AT_VS + (buf ^ 1) * 18432;
#pragma unroll
            for (int i = 0; i < 2; ++i) { const int r = sr0 + i * 32; *(LAS u32x4*)(Kn + (r * 136 + sc8) * 2) = cvraw(kr[i], isf); *(LAS u32x4*)(Vn + (r * 144 + sc8) * 2) = cvraw(vr[i], isf); } }
        __syncthreads();
    }
    l_run += __shfl_xor(l_run, 16); l_run += __shfl_xor(l_run, 32);
    LAS float* cm = (LAS float*)(L + AT_CM); LAS float* co = (LAS float*)(L + AT_CO);
    if (kh == 1) { if (fq == 0) { cm[qt * 16 + fr] = m_run; cm[64 + qt * 16 + fr] = l_run; }
#pragma unroll
        for (int i = 0; i < 8; ++i)
#pragma unroll
            for (int j = 0; j < 4; ++j) co[(qt * 128 + i * 16 + fq * 4 + j) * 16 + fr] = o[i][j]; }
    __syncthreads();
    if (kh == 0) { const float m1 = cm[qt * 16 + fr], l1 = cm[64 + qt * 16 + fr]; const float m = fmaxf(m_run, m1), a0 = __builtin_amdgcn_exp2f(m_run - m), a1 = __builtin_amdgcn_exp2f(m1 - m);
        const float inv = 1.0f / (l_run * a0 + l1 * a1);
#pragma unroll
        for (int i = 0; i < 8; ++i) { float r[4];
#pragma unroll
            for (int j = 0; j < 4; ++j) r[j] = (o[i][j] * a0 + co[(qt * 128 + i * 16 + fq * 4 + j) * 16 + fr] * a1) * inv;
            u32x2 pk; pk.x = cvt_pk_bf16(r[0], r[1]); pk.y = cvt_pk_bf16(r[2], r[3]); *(u32x2*)(O + (size_t)(qt * 16 + fr) * ldo + i * 16 + fq * 4) = pk; } }
}

constexpr int PA_VT = 0, PA_KT = 34816, PA_ES = 69632;
__device__ __forceinline__ void mlstm_pa(LAS unsigned char* L, int cs, int h, const bf16_t* Z, const float* IG, const float* LF, bf16_t* CD, float* DN, float* BL, float* GMAX) {
    const int tid = otid(), lane = tid & 63, w = tid >> 6, fr = lane & 15, fq = lane >> 4, row0 = cs * 64;
    LAS float* es = (LAS float*)(L + PA_ES);
    __syncthreads();
    if (w == 0) { float b = LF[(row0 + lane) * 4 + h]; const float ig = IG[(row0 + lane) * 4 + h];
#pragma unroll
        for (int off = 1; off < 64; off <<= 1) { const float v = __shfl_up(b, off); if (lane >= off) b += v; }
        const float bL = __shfl(b, 63); const float xg = ig - b; float mx = xg;
#pragma unroll
        for (int off = 1; off < 64; off <<= 1) mx = fmaxf(mx, __shfl_xor(mx, off));
        es[lane] = __expf(xg - mx);
        if (lane == 0) { BL[cs * 4 + h] = bL; GMAX[cs * 4 + h] = bL + mx; } }
    __syncthreads();
#pragma unroll
    for (int i = 0; i < 4; ++i) { const int idx = tid + i * 512, s = idx >> 5, c8 = (idx & 31) * 8; const float e = es[s];
        const u32x4 kw = *(const u32x4*)(Z + (size_t)(row0 + s) * NZ + 1024 + h * 256 + c8); *(LAS u32x4*)(L + PA_KT + (s * 272 + c8) * 2) = kw;
        u32x4 vw = *(const u32x4*)(Z + (size_t)(row0 + s) * NZ + 2048 + h * 256 + c8);
        vw.x = cvt_pk_bf16(bflo(vw.x) * e, bfhi(vw.x) * e); vw.y = cvt_pk_bf16(bflo(vw.y) * e, bfhi(vw.y) * e); vw.z = cvt_pk_bf16(bflo(vw.z) * e, bfhi(vw.z) * e); vw.w = cvt_pk_bf16(bflo(vw.w) * e, bfhi(vw.w) * e);
        *(LAS u32x4*)(L + PA_VT + (s * 272 + c8) * 2) = vw; }
    __syncthreads();
    bf16_t* Cd = CD + (size_t)(cs * 4 + h) * 65536;
    const int troff = ((4 * fq + (fr >> 2)) * 272 + (fr & 3) * 4) * 2;
#pragma unroll 1
    for (int vt = 0; vt < 2; ++vt) { const int vb = w * 32 + vt * 16;
        bf16x8 vf[2];
#pragma unroll
        for (int ks = 0; ks < 2; ++ks) { LAS unsigned char* a_ = L + PA_VT + troff + ks * 32 * 544 + vb * 2;
            const s16x4 v0 = __builtin_amdgcn_ds_read_tr16_b64_v4i16((LAS s16x4*)a_), v1 = __builtin_amdgcn_ds_read_tr16_b64_v4i16((LAS s16x4*)(a_ + 16 * 544));
            vf[ks] = (bf16x8){v0[0], v0[1], v0[2], v0[3], v1[0], v1[1], v1[2], v1[3]}; }
#pragma unroll 4
        for (int k2 = 0; k2 < 16; ++k2) { f32x4 a = (f32x4){0.f, 0.f, 0.f, 0.f};
#pragma unroll
            for (int ks = 0; ks < 2; ++ks) { LAS unsigned char* a_ = L + PA_KT + troff + ks * 32 * 544 + k2 * 32;
                const s16x4 k0 = __builtin_amdgcn_ds_read_tr16_b64_v4i16((LAS s16x4*)a_), k1 = __builtin_amdgcn_ds_read_tr16_b64_v4i16((LAS s16x4*)(a_ + 16 * 544));
                const bf16x8 kf = {k0[0], k0[1], k0[2], k0[3], k1[0], k1[1], k1[2], k1[3]}; a = mfma16(kf, vf[ks], a); }
            u32x2 pk; pk.x = cvt_pk_bf16(a[0], a[1]); pk.y = cvt_pk_bf16(a[2], a[3]); *(u32x2*)(Cd + (size_t)(vb + fr) * 256 + k2 * 16 + fq * 4) = pk; } }
    if (tid < 256) { float a = 0.f; LAS unsigned short* kS = (LAS unsigned short*)(L + PA_KT);
        for (int s = 0; s < 64; ++s) a += es[s] * __uint_as_float(((unsigned)kS[s * 272 + tid]) << 16);
        DN[(size_t)(cs * 4 + h) * 256 + tid] = a; }
}

__device__ __forceinline__ void mlstm_scan(LAS unsigned char* L, int l, const float* __restrict__ BL, const float* __restrict__ GMAX, float* __restrict__ MENT, bf16_t* CD, const float* __restrict__ DN, float* __restrict__ NENT,
                                           const float* __restrict__ sC, const float* __restrict__ sN, const float* __restrict__ sM, float* __restrict__ out) {
    const int tid = otid(); LAS float* As = (LAS float*)L; LAS float* Es = As + NCS * 4; LAS float* Bs = Es + NCS * 4; LAS float* Gs = Bs + NCS * 4; LAS float* Ms = Gs + NCS * 4;
    __syncthreads();
    for (int i = tid; i < NCS * 4; i += 512) { Bs[i] = BL[i]; Gs[i] = GMAX[i]; }
    __syncthreads();
    if (tid < 4) { const int h = tid; float m = 0.f;
        for (int c = 0; c < 128; ++c) { const float bL = Bs[c * 4 + h], gm = Gs[c * 4 + h], mn = fmaxf(bL + m, gm); As[c * 4 + h] = __expf(bL + m - mn); Es[c * 4 + h] = __expf(gm - mn); Ms[c * 4 + h] = m; m = mn; }
        if (blockIdx.x == 0) out[O_PM + l * 4 + h] = m; }
    else if (tid < 36) { const int b = (tid - 4) >> 2, h = (tid - 4) & 3, cs = 128 + b; const float m = sM[(l * 8 + b) * 4 + h];
        const float bL = Bs[cs * 4 + h], gm = Gs[cs * 4 + h], mn = fmaxf(bL + m, gm); As[cs * 4 + h] = __expf(bL + m - mn); Es[cs * 4 + h] = __expf(gm - mn); Ms[cs * 4 + h] = m;
        if (blockIdx.x == 0) out[O_SM + (l * 8 + b) * 4 + h] = mn; }
    __syncthreads();
    if (blockIdx.x == 0) for (int i = tid; i < NCS * 4; i += 512) MENT[i] = Ms[i];
    const int gt = obid() * 512 + tid, nthr = gridDim.x * 512;
    for (int p = gt; p < 131072; p += nthr) { const int h = p >> 15, e2 = (p & 32767) * 2;
        float c0 = 0.f, c1 = 0.f; unsigned* base = (unsigned*)(CD + (size_t)h * 65536 + e2);
        const float2 ci0 = *(const float2*)(sC + (size_t)((l * 8 + 0) * 4 + h) * 65536 + e2);
        unsigned dsm[8]; float2 cis[8];
#pragma unroll
        for (int b = 0; b < 8; ++b) { dsm[b] = base[(size_t)(128 + b) * (4 * 65536 / 2)]; cis[b] = *(const float2*)(sC + (size_t)((l * 8 + b) * 4 + h) * 65536 + e2); }
        (void)ci0;
        for (int c = 0; c < 128; c += 16) { unsigned d[16];
#pragma unroll
            for (int i = 0; i < 16; ++i) d[i] = base[(size_t)(c + i) * (4 * 65536 / 2)];
#pragma unroll
            for (int i = 0; i < 16; ++i) { base[(size_t)(c + i) * (4 * 65536 / 2)] = cvt_pk_bf16(c0, c1); const float a = As[(c + i) * 4 + h], e = Es[(c + i) * 4 + h]; c0 = a * c0 + e * bflo(d[i]); c1 = a * c1 + e * bfhi(d[i]); } }
        *(float2*)(out + O_PC + (size_t)(l * 4 + h) * 65536 + e2) = make_float2(c0, c1);
#pragma unroll
        for (int b = 0; b < 8; ++b) { const int cs = 128 + b; base[(size_t)cs * (4 * 65536 / 2)] = cvt_pk_bf16(cis[b].x, cis[b].y); const float a = As[cs * 4 + h], e = Es[cs * 4 + h];
            *(float2*)(out + O_SC + (size_t)((l * 8 + b) * 4 + h) * 65536 + e2) = make_float2(a * cis[b].x + e * bflo(dsm[b]), a * cis[b].y + e * bfhi(dsm[b])); } }
    for (int e = obid() * 4 + (tid >> 7); e < 1024; e += gridDim.x * 4) {
      if ((tid & 127) == 0) { const int h = e >> 8, k = e & 255; float n = 0.f;
        for (int c = 0; c < 128; c += 16) { float d[16];
#pragma unroll
            for (int i = 0; i < 16; ++i) d[i] = DN[(size_t)((c + i) * 4 + h) * 256 + k];
#pragma unroll
            for (int i = 0; i < 16; ++i) { NENT[(size_t)((c + i) * 4 + h) * 256 + k] = n; n = As[(c + i) * 4 + h] * n + Es[(c + i) * 4 + h] * d[i]; } }
        out[O_PN + (l * 4 + h) * 256 + k] = n;
#pragma unroll
        for (int b = 0; b < 8; ++b) { const int cs = 128 + b; const float ni = sN[((l * 8 + b) * 4 + h) * 256 + k]; const float d = DN[(size_t)(cs * 4 + h) * 256 + k]; NENT[(size_t)(cs * 4 + h) * 256 + k] = ni;
            out[O_SN + ((l * 8 + b) * 4 + h) * 256 + k] = As[cs * 4 + h] * ni + Es[cs * 4 + h] * d; } } }
}

constexpr int PC_QS = 0, PC_KS = 33792, PC_VT = 67584, PC_PS = 102400, PC_SC = 111616;
__device__ __forceinline__ void mlstm_pc(LAS unsigned char* L, int cs, int h, const bf16_t* Z, const float* IG, const float* LF, const bf16_t* CD, const float* NENT, const float* MENT,
                                         const float* ghead  , bf16_t* MIX) {
    const int tid = otid(), lane = tid & 63, w = tid >> 6, fr = lane & 15, fq = lane >> 4, row0 = cs * 64;
    LAS float* sc = (LAS float*)(L + PC_SC);
    LAS float* bcum = sc, *xgs = sc + 64, *mts = sc + 128, *wis = sc + 192, *dns = sc + 256, *psum = sc + 320, *hsq = sc + 576;
    __syncthreads();
    if (w == 0) { float b = LF[(row0 + lane) * 4 + h]; const float ig = IG[(row0 + lane) * 4 + h]; const float m = MENT[cs * 4 + h];
#pragma unroll
        for (int off = 1; off < 64; off <<= 1) { const float v = __shfl_up(b, off); if (lane >= off) b += v; }
        const float xg = ig - b; float pm = xg;
#pragma unroll
        for (int off = 1; off < 64; off <<= 1) { const float v = __shfl_up(pm, off); if (lane >= off) pm = fmaxf(pm, v); }
        const float Mx = fmaxf(m, pm); bcum[lane] = b; xgs[lane] = xg; mts[lane] = b + Mx; wis[lane] = __expf(m - Mx); }
    if (tid >= 256) sc[1088 + (tid - 256)] = NENT[(size_t)(cs * 4 + h) * 256 + (tid - 256)];
#pragma unroll
    for (int i = 0; i < 4; ++i) { const int idx = tid + i * 512, s = idx >> 5, c8 = (idx & 31) * 8; const bf16_t* zr = Z + (size_t)(row0 + s) * NZ + h * 256 + c8;
        *(LAS u32x4*)(L + PC_QS + (s * 264 + c8) * 2) = *(const u32x4*)(zr);
        *(LAS u32x4*)(L + PC_KS + (s * 264 + c8) * 2) = *(const u32x4*)(zr + 1024);
        *(LAS u32x4*)(L + PC_VT + (s * 272 + c8) * 2) = *(const u32x4*)(zr + 2048); }
    __syncthreads();
    {
        const int st = w >> 1, tt0 = (w & 1) * 2; f32x4 sa[2] = {(f32x4){0.f, 0.f, 0.f, 0.f}, (f32x4){0.f, 0.f, 0.f, 0.f}};
#pragma unroll
        for (int ks = 0; ks < 8; ++ks) { const bf16x8 kf = *(LAS bf16x8*)(L + PC_KS + ((st * 16 + fr) * 264 + ks * 32 + fq * 8) * 2);
#pragma unroll
            for (int i = 0; i < 2; ++i) { const bf16x8 qf = *(LAS bf16x8*)(L + PC_QS + (((tt0 + i) * 16 + fr) * 264 + ks * 32 + fq * 8) * 2); sa[i] = mfma16(kf, qf, sa[i]); } }
#pragma unroll
        for (int i = 0; i < 2; ++i) { const int t = (tt0 + i) * 16 + fr; const float ut = bcum[t] - mts[t]; float pr[4]; float rp = 0.f;
#pragma unroll
            for (int j = 0; j < 4; ++j) { const int s = st * 16 + fq * 4 + j; const float v = (s <= t) ? __expf(ut + xgs[s]) * sa[i][j] : 0.f; pr[j] = v; rp += v; }
            u32x2 pk; pk.x = cvt_pk_bf16(pr[0], pr[1]); pk.y = cvt_pk_bf16(pr[2], pr[3]); *(LAS u32x2*)(L + PC_PS + (t * 72 + st * 16 + fq * 4) * 2) = pk;
            rp += __shfl_xor(rp, 16); rp += __shfl_xor(rp, 32); if (fq == 0) psum[st * 64 + t] = rp; }
        const int t = tid >> 3, part = tid & 7; LAS float* nv = sc + 1088 + part * 32; float a = 0.f;
        LAS unsigned char* qrow = L + PC_QS + (t * 264 + part * 32) * 2;
#pragma unroll
        for (int d8 = 0; d8 < 4; ++d8) { const u32x4 qw = *(LAS u32x4*)(qrow + d8 * 16); const f32x4 n0 = *(LAS f32x4*)(nv + d8 * 8), n1 = *(LAS f32x4*)(nv + d8 * 8 + 4);
            a += n0[0] * bflo(qw.x) + n0[1] * bfhi(qw.x) + n0[2] * bflo(qw.y) + n0[3] * bfhi(qw.y) + n1[0] * bflo(qw.z) + n1[1] * bfhi(qw.z) + n1[2] * bflo(qw.w) + n1[3] * bfhi(qw.w); }
        a += __shfl_xor(a, 1); a += __shfl_xor(a, 2); a += __shfl_xor(a, 4); if (part == 0) dns[t] = a;
    }
    __syncthreads();
    const int v0 = w * 32; const bf16_t* Cg = CD + (size_t)(cs * 4 + h) * 65536;
    f32x4 acc[2][4];
#pragma unroll
    for (int vt = 0; vt < 2; ++vt)
#pragma unroll
        for (int tt = 0; tt < 4; ++tt) acc[vt][tt] = (f32x4){0.f, 0.f, 0.f, 0.f};
    __builtin_amdgcn_s_setprio(1);
#pragma unroll
    for (int ks = 0; ks < 8; ++ks) { bf16x8 cf[2];
#pragma unroll
        for (int vt = 0; vt < 2; ++vt) cf[vt] = *(const bf16x8*)(Cg + (size_t)(v0 + vt * 16 + fr) * 256 + ks * 32 + fq * 8);
#pragma unroll
        for (int tt = 0; tt < 4; ++tt) { const bf16x8 qf = *(LAS bf16x8*)(L + PC_QS + ((tt * 16 + fr) * 264 + ks * 32 + fq * 8) * 2);
#pragma unroll
            for (int vt = 0; vt < 2; ++vt) acc[vt][tt] = mfma16(cf[vt], qf, acc[vt][tt]); } }
    __builtin_amdgcn_s_setprio(0);
    float dd[4];
#pragma unroll
    for (int tt = 0; tt < 4; ++tt) { const int t = tt * 16 + fr; const float wi = wis[t];
        const float den = wi * dns[t] + ((psum[t] + psum[64 + t]) + (psum[128 + t] + psum[192 + t])); dd[tt] = 1.0f / fmaxf(fabsf(den), __expf(-mts[t]));
#pragma unroll
        for (int vt = 0; vt < 2; ++vt) acc[vt][tt] = acc[vt][tt] * wi; }
#pragma unroll
    for (int ks = 0; ks < 2; ++ks) { bf16x8 vf[2];
#pragma unroll
        for (int vt = 0; vt < 2; ++vt) { LAS unsigned char* a_ = L + PC_VT + ((ks * 32 + 4 * fq + (fr >> 2)) * 272 + (fr & 3) * 4 + v0 + vt * 16) * 2;
            const s16x4 x0 = __builtin_amdgcn_ds_read_tr16_b64_v4i16((LAS s16x4*)a_), x1 = __builtin_amdgcn_ds_read_tr16_b64_v4i16((LAS s16x4*)(a_ + 16 * 544));
            vf[vt] = (bf16x8){x0[0], x0[1], x0[2], x0[3], x1[0], x1[1], x1[2], x1[3]}; }
#pragma unroll
        for (int tt = 0; tt < 4; ++tt) { LAS unsigned char* b_ = L + PC_PS + ((tt * 16 + fr) * 72 + ks * 32 + fq * 4) * 2;
            const u32x2 p0 = *(LAS u32x2*)b_, p1 = *(LAS u32x2*)(b_ + 32); const u32x4 pw = {p0.x, p0.y, p1.x, p1.y}; const bf16x8 pf = __builtin_bit_cast(bf16x8, pw);
#pragma unroll
            for (int vt = 0; vt < 2; ++vt) acc[vt][tt] = mfma16(vf[vt], pf, acc[vt][tt]); } }
#pragma unroll
    for (int tt = 0; tt < 4; ++tt) { float q = 0.f;
#pragma unroll
        for (int vt = 0; vt < 2; ++vt) { acc[vt][tt] = acc[vt][tt] * dd[tt]; q += acc[vt][tt][0] * acc[vt][tt][0] + acc[vt][tt][1] * acc[vt][tt][1] + acc[vt][tt][2] * acc[vt][tt][2] + acc[vt][tt][3] * acc[vt][tt][3]; }
        q += __shfl_xor(q, 16); q += __shfl_xor(q, 32); if (fq == 0) hsq[w * 64 + tt * 16 + fr] = q; }
    __syncthreads();
#pragma unroll
    for (int tt = 0; tt < 4; ++tt) { const int t = tt * 16 + fr; float tot = 0.f;
#pragma unroll
        for (int ww = 0; ww < 8; ++ww) tot += hsq[ww * 64 + t];
        const float rn = rsqrtf(tot * (1.0f / 256.0f) + 1e-6f); const size_t row = (size_t)(row0 + t);
#pragma unroll
        for (int vt = 0; vt < 2; ++vt) { const int v = v0 + vt * 16 + fq * 4; const u32x2 ow = *(const u32x2*)(Z + row * NZ + 3072 + h * 256 + v); const f32x4 gh = *(const f32x4*)(ghead + h * 256 + v);
            const f32x4 hv = acc[vt][tt] * rn * gh; u32x2 pk; pk.x = cvt_pk_bf16(bflo(ow.x) * hv[0], bfhi(ow.x) * hv[1]); pk.y = cvt_pk_bf16(bflo(ow.y) * hv[2], bfhi(ow.y) * hv[3]);
            *(u32x2*)(MIX + row * DM + h * 256 + v) = pk; } }
}

__device__ __forceinline__ void conv_phase(int l, const bf16_t* __restrict__ U, const float* __restrict__ cw  , const float* __restrict__ cb, const float* __restrict__ sconv  , bf16_t* __restrict__ ACT) {
    const int gt = obid() * 512 + otid(), nthr = gridDim.x * 512;
    for (int task_ = gt; task_ < 272 * 704; task_ += nthr) { const int task = 272 * 704 - 1 - task_;
        const int rr = task / 704, cgi = task - rr * 704, j0 = cgi * 8, r0 = rr * 32;
        float pa2[8], pa1[8], pb2[8], pb1[8];
        const bool seq_start = (r0 < 8192) ? (r0 == 0) : (((r0 - 8192) & 63) == 0);
        if (seq_start) {
            if (r0 == 0) {
#pragma unroll
                for (int i = 0; i < 8; ++i) { pa2[i] = 0.f; pa1[i] = 0.f; pb2[i] = 0.f; pb1[i] = 0.f; } }
            else { const int b = (r0 - 8192) >> 6; const float* s0 = sconv + (size_t)(b * 2) * DFF2; const float* s1 = s0 + DFF2;
#pragma unroll
                for (int i = 0; i < 8; ++i) { pa2[i] = s0[j0 + i]; pa1[i] = s1[j0 + i]; pb2[i] = s0[DFF + j0 + i]; pb1[i] = s1[DFF + j0 + i]; } } }
        else { const u32x4 a2 = *(const u32x4*)(U + (size_t)(r0 - 2) * DFF2 + j0), a1 = *(const u32x4*)(U + (size_t)(r0 - 1) * DFF2 + j0),
                           b2 = *(const u32x4*)(U + (size_t)(r0 - 2) * DFF2 + DFF + j0), b1 = *(const u32x4*)(U + (size_t)(r0 - 1) * DFF2 + DFF + j0);
            pa2[0] = bflo(a2.x); pa2[1] = bfhi(a2.x); pa2[2] = bflo(a2.y); pa2[3] = bfhi(a2.y); pa2[4] = bflo(a2.z); pa2[5] = bfhi(a2.z); pa2[6] = bflo(a2.w); pa2[7] = bfhi(a2.w);
            pa1[0] = bflo(a1.x); pa1[1] = bfhi(a1.x); pa1[2] = bflo(a1.y); pa1[3] = bfhi(a1.y); pa1[4] = bflo(a1.z); pa1[5] = bfhi(a1.z); pa1[6] = bflo(a1.w); pa1[7] = bfhi(a1.w);
            pb2[0] = bflo(b2.x); pb2[1] = bfhi(b2.x); pb2[2] = bflo(b2.y); pb2[3] = bfhi(b2.y); pb2[4] = bflo(b2.z); pb2[5] = bfhi(b2.z); pb2[6] = bflo(b2.w); pb2[7] = bfhi(b2.w);
            pb1[0] = bflo(b1.x); pb1[1] = bfhi(b1.x); pb1[2] = bflo(b1.y); pb1[3] = bfhi(b1.y); pb1[4] = bflo(b1.z); pb1[5] = bfhi(b1.z); pb1[6] = bflo(b1.w); pb1[7] = bfhi(b1.w); }
        float wa0[8], wa1[8], wa2[8], ba[8], wb0[8], wb1[8], wb2[8], bb[8];
#pragma unroll
        for (int i = 0; i < 8; ++i) { wa0[i] = cw[j0 + i]; wa1[i] = cw[DFF2 + j0 + i]; wa2[i] = cw[2 * DFF2 + j0 + i]; ba[i] = cb[j0 + i];
            wb0[i] = cw[DFF + j0 + i]; wb1[i] = cw[DFF2 + DFF + j0 + i]; wb2[i] = cw[2 * DFF2 + DFF + j0 + i]; bb[i] = cb[DFF + j0 + i]; }
#pragma unroll 4
        for (int r = 0; r < 32; ++r) { const size_t row = (size_t)(r0 + r);
            const u32x4 ua = *(const u32x4*)(U + row * DFF2 + j0), ub = *(const u32x4*)(U + row * DFF2 + DFF + j0);
            float ca[8], cbv[8];
            ca[0] = bflo(ua.x); ca[1] = bfhi(ua.x); ca[2] = bflo(ua.y); ca[3] = bfhi(ua.y); ca[4] = bflo(ua.z); ca[5] = bfhi(ua.z); ca[6] = bflo(ua.w); ca[7] = bfhi(ua.w);
            cbv[0] = bflo(ub.x); cbv[1] = bfhi(ub.x); cbv[2] = bflo(ub.y); cbv[3] = bfhi(ub.y); cbv[4] = bflo(ub.z); cbv[5] = bfhi(ub.z); cbv[6] = bflo(ub.w); cbv[7] = bfhi(ub.w);
            float res[8];
#pragma unroll
            for (int i = 0; i < 8; ++i) { const float a = ba[i] + wa0[i] * pa2[i] + wa1[i] * pa1[i] + wa2[i] * ca[i]; const float b = bb[i] + wb0[i] * pb2[i] + wb1[i] * pb1[i] + wb2[i] * cbv[i];
                res[i] = a * __builtin_amdgcn_rcpf(1.0f + __expf(-a)) * b; pa2[i] = pa1[i]; pa1[i] = ca[i]; pb2[i] = pb1[i]; pb1[i] = cbv[i]; }
            u32x4 o; o.x = cvt_pk_bf16(res[0], res[1]); o.y = cvt_pk_bf16(res[2], res[3]); o.z = cvt_pk_bf16(res[4], res[5]); o.w = cvt_pk_bf16(res[6], res[7]);
            *(u32x4*)(ACT + row * DFF + j0) = o; } }
}


#define XB_TMO      128
#define XB_XCNT(j)  (256  + 64 * (j))
#define XB_XSUB(j)  (1280 + 64 * (j))
#define XB_XGEN(j)  (2304 + 64 * (j))
#define XB_TOP      3328
#define XB_TOPGEN   3392
#define XCD_BAR_WORDS 3456
#define XB_SPIN_CAP (1u << 18)

__device__ __forceinline__ unsigned xb_ld(unsigned* p)              { return __hip_atomic_load(p, __ATOMIC_RELAXED, __HIP_MEMORY_SCOPE_AGENT); }
__device__ __forceinline__ unsigned xb_add(unsigned* p, unsigned v) { return __hip_atomic_fetch_add(p, v, __ATOMIC_RELAXED, __HIP_MEMORY_SCOPE_AGENT); }
__device__ __forceinline__ unsigned xb_xcc_id() { return (unsigned)__builtin_amdgcn_s_getreg((3 << 11) | 20) & 0xFu; }
#define XB_SPIN(cond, bar) do { unsigned _sp = 0; while (cond) { __builtin_amdgcn_s_sleep(1); \
    if ((++_sp & 255u) == 0u) { if (xb_ld(&(bar)[XB_TMO])) break; if (_sp > XB_SPIN_CAP) { atomicAdd(&(bar)[XB_TMO], 1u); break; } } } } while (0)

struct XcdBarrier {
    unsigned* bar; unsigned x;
    volatile LAS unsigned* st;
};

__device__ __forceinline__ XcdBarrier xcd_barrier_post(unsigned* bar, volatile LAS unsigned* st) {
    XcdBarrier b; b.bar = bar; b.x = xb_xcc_id(); b.st = st;
    if (threadIdx.x == 0) (void)xb_add(&bar[XB_XCNT(b.x)], 1u);
    return b;
}
__device__ __forceinline__ void xcd_barrier_complete(unsigned* bar, unsigned x, unsigned& nloc, unsigned& nx) {
    const unsigned G = gridDim.x * gridDim.y * gridDim.z;
    unsigned sum, cnt, mine, sp = 0u;
    for (;;) {
        sum = 0u; cnt = 0u; mine = 0u;
#pragma unroll
        for (unsigned j = 0; j < 16; ++j) { const unsigned c = xb_ld(&bar[XB_XCNT(j)]); sum += c; cnt += (c > 0u) ? 1u : 0u; mine = (j == x) ? c : mine; }
        if (sum == G) break;
        __builtin_amdgcn_s_sleep(1);
        if ((++sp & 255u) == 0u) { if (xb_ld(&bar[XB_TMO])) break; if (sp > XB_SPIN_CAP) { atomicAdd(&bar[XB_TMO], 1u); break; } }
    }
    nloc = mine > 0u ? mine : 1u; nx = cnt > 0u ? cnt : 1u;
}

__device__ __forceinline__ void xcd_barrier(const XcdBarrier& b) {
    asm volatile("s_waitcnt vmcnt(0)" ::: "memory");
    __syncthreads();
    if (threadIdx.x == 0) {
        unsigned* bar = b.bar;
        __builtin_amdgcn_s_waitcnt(0);
        unsigned nloc = b.st[0], nx = b.st[1];
        if (nloc == 0u) { xcd_barrier_complete(bar, b.x, nloc, nx); b.st[0] = nloc; b.st[1] = nx; }
        const unsigned old = xb_add(&bar[XB_XSUB(b.x)], 1u);
        const unsigned gen = old / nloc;
        if (old + 1u == (gen + 1u) * nloc) {
            __builtin_amdgcn_fence(__ATOMIC_RELEASE, "agent");
            asm volatile("s_waitcnt vmcnt(0)" ::: "memory");
            const unsigned og = xb_add(&bar[XB_TOP], 1u);
            const unsigned tg = og / nx;
            if (og + 1u == (tg + 1u) * nx) xb_add(&bar[XB_TOPGEN], 1u);
            else XB_SPIN(xb_ld(&bar[XB_TOPGEN]) == tg, bar);
            __builtin_amdgcn_fence(__ATOMIC_ACQUIRE, "agent");
            xb_add(&bar[XB_XGEN(b.x)], 1u);
            asm volatile("s_waitcnt vmcnt(0)" ::: "memory");
        } else {
            XB_SPIN(xb_ld(&bar[XB_XGEN(b.x)]) == gen, bar);
            __builtin_amdgcn_fence(__ATOMIC_ACQUIRE, "agent");
            asm volatile("s_waitcnt vmcnt(0)" ::: "memory");
        }
    }
    __syncthreads();
}


typedef __attribute__((address_space(1))) float* gfptr_t;
typedef const gfptr_t __attribute__((address_space(4)))* ktab_t;
__device__ __forceinline__ const float* ldarg(int i) { ktab_t t = (ktab_t)__builtin_amdgcn_kernarg_segment_ptr(); asm volatile("" : "+s"(t)); const gfptr_t g = t[i]; return (const float*)g; }
#define WSB ((unsigned char*)ldarg(30))
#define OUTB ((float*)ldarg(29))
#define gX_ ((float*)(WSB + WS_X))
#define gH_ ((bf16_t*)(WSB + WS_H))
#define gZ_ ((bf16_t*)(WSB + WS_Z))
#define gCD_ ((bf16_t*)(WSB + WS_CD))
#define gU_ ((bf16_t*)(WSB + WS_U))
#define gMIX_ ((bf16_t*)(WSB + WS_MIX))
#define gQC_ ((bf16_t*)(WSB + WS_QC))
#define gOC_ ((bf16_t*)(WSB + WS_OC))
#define gACT_ ((bf16_t*)(WSB + WS_ACT))
#define gIG_ ((float*)(WSB + WS_IG))
#define gLF_ ((float*)(WSB + WS_LF))
#define gBL_ ((float*)(WSB + WS_BL))
#define gGMAX_ ((float*)(WSB + WS_GMAX))
#define gMENT_ ((float*)(WSB + WS_MENT))
#define gDN_ ((float*)(WSB + WS_DN))
#define gNENT_ ((float*)(WSB + WS_NENT))
#define gPART_ ((float*)(WSB + WS_D))
#define gTT_ ((int*)(WSB + WS_TT))
__global__ void __launch_bounds__(512, 2) mega(Params p) {
    extern __shared__ __attribute__((aligned(16))) unsigned char lds_raw[];
    LAS unsigned char* L = (LAS unsigned char*)lds_raw;
    cg::grid_group grid = cg::this_grid();
    volatile LAS unsigned* xst = (volatile LAS unsigned*)(L + 131072);
    if (threadIdx.x < 4) xst[threadIdx.x] = 0u;
    __syncthreads();
    const XcdBarrier xbar = xcd_barrier_post((unsigned*)(p.ws + WS_BAR), xst);
    if (p.out == nullptr) grid.sync();
#define GSYNC() xcd_barrier(xbar)

    { int* tt_ = gTT_;
    if (blockIdx.x == 0 && threadIdx.x < 272) { pg8::StaticOrder S_; S_.init(MT, 2048, (int)gridDim.x, 0); pg8::Unit u_; S_.map((int)threadIdx.x, u_); tt_[u_.pm * 8 + u_.pn] = (threadIdx.x >= 256) ? (int)threadIdx.x - 255 : 0; } }

#if STOP_AFTER != 0
    { float* o_ = OUTB; for (size_t i = (size_t)blockIdx.x * 512 + threadIdx.x; i < O_END; i += (size_t)gridDim.x * 512) o_[i] = 0.f; }
#endif
    for (int rep_ = 0; rep_ < REP_P0; ++rep_)
    for (int li = 0; li < 2; ++li) { const int l = 1 - li; unsigned char* wl = WSB + (size_t)l * SZ_LAYER;
        convw(L, ldarg(I_WDN) + (size_t)l * DFF * 2048, 2048, DFF, 2048, (bf16_t*)(wl + OFF_WDN), 0);
        convw(L, ldarg(I_WUP) + (size_t)l * 2048 * DFF2, DFF2, 2048, DFF2, (bf16_t*)(wl + OFF_WUP), 0);
        convw(L, ldarg(I_WCO) + (size_t)l * 512 * 2048, 2048, 512, 2048, (bf16_t*)(wl + OFF_WCO), 0);
        convw(L, ldarg(I_WCQ) + (size_t)l * 2048 * 512, 512, 2048, 512, (bf16_t*)(wl + OFF_WCQ), 0);
        convw(L, ldarg(I_WOUT) + (size_t)l * 2048 * 2048, 2048, 2048, 2048, (bf16_t*)(wl + OFF_WOUT), 0);
        convw(L, ldarg(I_WCKV) + (size_t)l * 2048 * 1024, 1024, 2048, 1024, (bf16_t*)(wl + OFF_WCKV), 0);
        convw(L, ldarg(I_WIN) + (size_t)l * 2048 * 7176, 7176, 2048, 7168, (bf16_t*)(wl + OFF_WIN), 1);
        float* WG = (float*)(wl + OFF_WG); const float* win = ldarg(I_WIN) + (size_t)l * 2048 * 7176;
        for (int i = blockIdx.x * 512 + threadIdx.x; i < 8 * 2048; i += gridDim.x * 512) { const int j = i >> 11, k = i & 2047; WG[i] = win[(size_t)k * 7176 + 3072 + j]; }
        norm_phase(L, nullptr, nullptr, (float*)ldarg(I_MEM), ldarg(I_GMEM) + l * DM, (bf16_t*)(WSB + WS_HMEM) + (size_t)l * 256 * 2048, nullptr, 256, 0, nullptr, nullptr, nullptr, nullptr, nullptr);
    }
    GSYNC();
#if STOP_AFTER == 1
        return;
#endif
    for (int l = 0; l < 2; ++l) {
        EpiGen E{(bf16_t*)(WSB + WS_MKV) + (size_t)l * 256 * 1024, 1024, 0};
        run_gemm(L, (const bf16_t*)(WSB + WS_HMEM) + (size_t)l * 256 * 2048, (const bf16_t*)(WSB + (size_t)l * SZ_LAYER + OFF_WCKV), 256, 1024, 2048, E, -1, 0, l == 0 ? 0 : (int)gridDim.x - 4);
    }
    for (int l = 0; l < 2; ++l) {
        unsigned char* wl = WSB + (size_t)l * SZ_LAYER;
        norm_phase(L, ldarg(I_XP), ldarg(I_XS), gX_, ldarg(I_GMIX) + l * DM, gH_, nullptr, MT, (l == 0 ? 1 : 0) | 2, (const float*)(wl + OFF_WG), ldarg(I_BI) + l * 4, ldarg(I_BF) + l * 4, gIG_, gLF_, gTT_, gPART_, l == 0 ? 0 : 11, l == 0 ? 8 : 0);
        GSYNC();
#if STOP_AFTER == 2
        return;
#endif
        { EpiGen E{gZ_, NZ, 1};
          for (int rep_ = 0; rep_ < REP_GI; ++rep_) run_gemm(L, gH_, (const bf16_t*)(wl + OFF_WIN), MT, NZ, 2048, E); }
        GSYNC();
#if STOP_AFTER == 3
#ifdef DUMP3
        { const size_t gt_ = (size_t)blockIdx.x * 512 + threadIdx.x, nt_ = (size_t)gridDim.x * 512;
          for (size_t i = gt_; i < 34816; i += nt_) { OUTB[i] = gIG_[i]; OUTB[40000 + i] = gLF_[i]; }
          for (size_t i = gt_; i < 15000000; i += nt_) OUTB[100000 + i] = __uint_as_float(((unsigned)gZ_[4 * i + (i & 3)]) << 16); }
#endif
        return;
#endif
        for (int r = 0; r < 7; ++r) {
            const int bx = (int)blockIdx.x; int i;
            if (r < 6) i = r * 256 + ((r & 1) ? 255 - bx : bx);
            else { const int bb = bx - 96; if (bb < 0 || bb >= 96) break; i = 1536 + bb; }
            if (i < 1088) {
                if (i < 64) { const int b = i >> 3, h = i & 7; attn_unit<true>(L, 1, l, b, h, gZ_ + (size_t)(8192 + b * 64) * NZ + 4096 + h * 128, NZ, gZ_, nullptr, ldarg(I_CAK), ldarg(I_CAV), ldarg(I_REL) + (size_t)(l * 8 + h) * 513, gMIX_ + (size_t)(8192 + b * 64) * DM + 1024 + h * 128, DM); }
                else { const int c = (i < 1024) ? 8 + ((i - 64) >> 3) : 7 - ((i - 1024) >> 3), h = i & 7; attn_unit<true>(L, 0, l, c, h, gZ_ + (size_t)(c * 64) * NZ + 4096 + h * 128, NZ, gZ_, nullptr, nullptr, nullptr, ldarg(I_REL) + (size_t)(l * 8 + h) * 513, gMIX_ + (size_t)(c * 64) * DM + 1024 + h * 128, DM); }
            } else { const int j = i - 1088; mlstm_pa(L, j >> 2, j & 3, gZ_, gIG_, gLF_, gCD_, gDN_, gBL_, gGMAX_); }
        }
        GSYNC();
#if STOP_AFTER == 4
#ifdef DUMP4
        { const size_t gt_ = (size_t)blockIdx.x * 512 + threadIdx.x, nt_ = (size_t)gridDim.x * 512;
          for (size_t i = gt_; i < 544; i += nt_) { OUTB[i] = gBL_[i]; OUTB[1000 + i] = gGMAX_[i]; }
#if DUMP4 == 1
          for (size_t i = gt_; i < 544 * 256; i += nt_) OUTB[2000 + i] = gDN_[i];
#endif
#if DUMP4 == 2
          for (size_t i = gt_; i < 15000000; i += nt_) OUTB[200000 + i] = __uint_as_float(((unsigned)gCD_[2 * i + (i & 1)]) << 16);
#endif
        }
#endif
        return;
#endif
        mlstm_scan(L, l, gBL_, gGMAX_, gMENT_, gCD_, gDN_, gNENT_, ldarg(I_SC), ldarg(I_SN), ldarg(I_SM), OUTB);
        copy_bf_f32(gZ_ + (size_t)7680 * NZ + 5120, NZ, OUTB + O_PK + (size_t)l * 512 * 1024, 1024, 512, 128);
        copy_bf_f32(gZ_ + (size_t)7680 * NZ + 6144, NZ, OUTB + O_PV + (size_t)l * 512 * 1024, 1024, 512, 128);
        copy_bf_f32(gZ_ + (size_t)8192 * NZ + 5120, NZ, OUTB + O_SK + (size_t)l * 512 * 1024, 1024, 512, 128);
        copy_bf_f32(gZ_ + (size_t)8192 * NZ + 6144, NZ, OUTB + O_SV + (size_t)l * 512 * 1024, 1024, 512, 128);
        GSYNC();
#if STOP_AFTER == 5
        return;
#endif
        for (int rep_ = 0; rep_ < REP_PC; ++rep_)
        for (int u = blockIdx.x; u < NCS * 4; u += gridDim.x) mlstm_pc(L, u >> 2, u & 3, gZ_, gIG_, gLF_, gCD_, gNENT_, gMENT_, ldarg(I_GHEAD) + l * 1024, gMIX_);
        GSYNC();
#if STOP_AFTER == 6
        return;
#endif
        { EpiRes E{gX_, 0, nullptr}; run_gemm(L, gMIX_, (const bf16_t*)(wl + OFF_WOUT), MT, 2048, 2048, E, 256, 0); EpiRes E2{gX_, 8, gPART_}; run_gemm(L, gMIX_, (const bf16_t*)(wl + OFF_WOUT), MT, 2048, 2048, E2, 256, 8); }
        GSYNC();
#if STOP_AFTER == 7
        return;
#endif
        for (int rep_ = 0; rep_ < REP_NB; ++rep_)
        norm_phase(L, nullptr, nullptr, gX_, ldarg(I_GCROSS) + l * DM, gH_, nullptr, MT, 0, nullptr, nullptr, nullptr, nullptr, nullptr, gTT_, gPART_, 8);
        GSYNC();
#if STOP_AFTER == 8
        return;
#endif
        { EpiRes E{nullptr, -1, (float*)(WSB + WS_QCF)}; run_gemm(L, gH_, (const bf16_t*)(wl + OFF_WCQ), MT, 512, 2048, E, 0, 2); }
        GSYNC();
#if STOP_AFTER == 9
        return;
#endif
        for (int rep_ = 0; rep_ < REP_XA; ++rep_)
        for (int u = blockIdx.x; u < NCS * 4; u += gridDim.x) { const int cr = u >> 2, h = u & 3;
            if (cr < 128) attn_unit<false>(L, 2, l, cr, h, gQC_ + (size_t)(cr * 64) * 512 + h * 128, 512, nullptr, (const bf16_t*)(WSB + WS_MKV) + (size_t)l * 256 * 1024, nullptr, nullptr, nullptr, gOC_ + (size_t)(cr * 64) * 512 + h * 128, 512, (const float*)(WSB + WS_QCF) + (size_t)(cr * 64) * 512 + h * 128);
            else attn_unit<false>(L, 3, l, cr - 128, h, gQC_ + (size_t)(cr * 64) * 512 + h * 128, 512, nullptr, nullptr, ldarg(I_CMK), ldarg(I_CMV), nullptr, gOC_ + (size_t)(cr * 64) * 512 + h * 128, 512, (const float*)(WSB + WS_QCF) + (size_t)(cr * 64) * 512 + h * 128); }
        GSYNC();
#if STOP_AFTER == 10
        return;
#endif
        { EpiRes E{gX_, 0, nullptr}; run_gemm(L, gOC_, (const bf16_t*)(wl + OFF_WCO), MT, 2048, 512, E, 256, 0); EpiRes E2{gX_, 2, gPART_}; run_gemm(L, gOC_, (const bf16_t*)(wl + OFF_WCO), MT, 2048, 512, E2, 256, 2); }
        GSYNC();
#if STOP_AFTER == 11
        return;
#endif
        norm_phase(L, nullptr, nullptr, gX_, ldarg(I_GFFN) + l * DM, gH_, nullptr, MT, 0, nullptr, nullptr, nullptr, nullptr, nullptr, gTT_, gPART_, 2);
        GSYNC();
#if STOP_AFTER == 12
        return;
#endif
        { EpiGen E{gU_, DFF2, 0}; for (int rep_ = 0; rep_ < REP_GU; ++rep_) run_gemm(L, gH_, (const bf16_t*)(wl + OFF_WUP), MT, DFF2, 2048, E); }
        GSYNC();
#if STOP_AFTER == 13
        return;
#endif
        for (int rep_ = 0; rep_ < REP_CV; ++rep_)
        copy_bf_f32((const bf16_t*)(WSB + WS_MKV) + (size_t)l * 256 * 1024, 1024, OUTB + O_PMK + (size_t)l * 256 * 512, 512, 256, 64);
        copy_bf_f32((const bf16_t*)(WSB + WS_MKV) + (size_t)l * 256 * 1024 + 512, 1024, OUTB + O_PMV + (size_t)l * 256 * 512, 512, 256, 64);
        copy_bf_f32(gU_ + (size_t)8190 * DFF2, DFF2, OUTB + O_PCONV + (size_t)l * 2 * DFF2, DFF2, 2, DFF2 / 8);
        for (int b = 0; b < 8; ++b) copy_bf_f32(gU_ + (size_t)(8192 + b * 64 + 62) * DFF2, DFF2, OUTB + O_SCONV + (size_t)(l * 16 + b * 2) * DFF2, DFF2, 2, DFF2 / 8);
        conv_phase(l, gU_, ldarg(I_CONVW) + (size_t)l * 3 * DFF2, ldarg(I_CONVB) + (size_t)l * DFF2, ldarg(I_SCONV) + (size_t)l * 16 * DFF2, gACT_);
        GSYNC();
#if STOP_AFTER == 14
        return;
#endif
        { EpiRes E{gX_, 0, nullptr}; run_gemm(L, gACT_, (const bf16_t*)(wl + OFF_WDN), MT, 2048, DFF, E, 256, 0); EpiRes E2{gX_, 11, gPART_}; run_gemm(L, gACT_, (const bf16_t*)(wl + OFF_WDN), MT, 2048, DFF, E2, 256, 11); }
        GSYNC();
#if STOP_AFTER == 15
        return;
#endif
    }
    norm_phase(L, nullptr, nullptr, gX_, ldarg(I_GFINAL), nullptr, OUTB, MT, 4, nullptr, nullptr, nullptr, nullptr, nullptr, gTT_, gPART_, 11);
}

extern "C" void kernel_launch(void* const* d_in, const int* in_sizes, int n_in, void* d_out, int out_size, void* d_ws, size_t ws_size, hipStream_t stream) {
    static int grid_blocks = 0;
    if (grid_blocks == 0) {
        if (n_in != 29 || (size_t)out_size != O_END || ws_size < WS_END) { fprintf(stderr, "kernel_launch: unexpected sizes n_in %d out %d ws %zu (need %zu)\n", n_in, out_size, ws_size, (size_t)WS_END); grid_blocks = -1; return; }
        int dev = 0, cus = 0, per_cu = 0;
        hipGetDevice(&dev); hipDeviceGetAttribute(&cus, hipDeviceAttributeMultiprocessorCount, dev);
        hipFuncSetAttribute((const void*)mega, hipFuncAttributeMaxDynamicSharedMemorySize, LDS_BYTES);
        hipOccupancyMaxActiveBlocksPerMultiprocessor(&per_cu, (const void*)mega, 512, LDS_BYTES);
        if (per_cu < 1) { fprintf(stderr, "kernel_launch: occupancy query says %d blocks per CU\n", per_cu); per_cu = 1; }
        (void)hipGetLastError();
        grid_blocks = 256;
        if (cus * per_cu < 256) fprintf(stderr, "kernel_launch: this kernel needs 256 co-resident workgroups, the device offers %d\n", cus * per_cu);
    }
    if (grid_blocks < 0) return;
    if (hipMemsetAsync((char*)d_ws + WS_BAR, 0, 16384, stream) != hipSuccess) return;
    Params p{};
    for (int i = 0; i < 29; ++i) p.in[i] = (const float*)d_in[i];
    p.out = (float*)d_out; p.ws = (unsigned char*)d_ws;
    void* args[] = {&p};
    hipError_t e = hipLaunchCooperativeKernel((const void*)mega, dim3(grid_blocks), dim3(512), args, LDS_BYTES, stream);
    if (e != hipSuccess) fprintf(stderr, "cooperative launch failed: %s (grid %d)\n", hipGetErrorString(e), grid_blocks);
}
```
